# Optimizing an MI355X kernel written in HIP

```python
import jax, jax.numpy as jnp
from jax import lax
import numpy as np

D_MODEL = 2048
BATCH = 1
SEQ = 8192
DEPTH = 4

GRID_W = 64
MLA_HEADS = 8
Q_LORA = 512
KV_LORA = 512
QK_NOPE = 128
QK_ROPE = 64
V_HEAD = 128
ROPE_THETA = 10000.0
Q_BLOCK = 128
NA_HEADS = 8
NA_HEAD_DIM = 128
NA_KH = 8
NA_KW = 16
D_FF = 4 * D_MODEL
EPS = 1e-6

MLA_W = MLA_HEADS * V_HEAD
NA_W = NA_HEADS * NA_HEAD_DIM
IN_WIDTHS = (Q_LORA, KV_LORA, QK_ROPE, NA_W, NA_W, NA_W, D_MODEL, D_MODEL)
IN_SPLITS = tuple(int(v) for v in np.cumsum(IN_WIDTHS)[:-1])
IN_TOTAL = int(sum(IN_WIDTHS))

kernel_name = "hybrid_mla_natten_sqrelu_encoder"


def rmsnorm(x, g):
    xf = x.astype(jnp.float32)
    y = xf * lax.rsqrt(jnp.mean(xf * xf, axis=-1, keepdims=True) + EPS)
    return (y * g.astype(jnp.float32)).astype(x.dtype)


def rope(x, cos, sin):
    x1, x2 = jnp.split(x, 2, axis=-1)
    return jnp.concatenate([x1 * cos - x2 * sin, x2 * cos + x1 * sin], axis=-1)


def mla_attention(q_nope, q_pe, k_nope, k_pe, v):
    B, S, H, _ = q_nope.shape
    nblk = S // Q_BLOCK
    scale = (QK_NOPE + QK_ROPE) ** -0.5
    qn_b = q_nope.reshape(B, nblk, Q_BLOCK, H, QK_NOPE).transpose(1, 0, 2, 3, 4)
    qp_b = q_pe.reshape(B, nblk, Q_BLOCK, H, QK_ROPE).transpose(1, 0, 2, 3, 4)

    def block(args):
        qn, qp = args
        s = (jnp.einsum('bqhd,bkhd->bhqk', qn, k_nope)
             + jnp.einsum('bqhd,bkd->bhqk', qp, k_pe)).astype(jnp.float32) * scale
        p = jax.nn.softmax(s, axis=-1).astype(v.dtype)
        return jnp.einsum('bhqk,bkhd->bqhd', p, v)

    out = lax.map(block, (qn_b, qp_b))
    return out.transpose(1, 0, 2, 3, 4).reshape(B, S, H * V_HEAD)


def neighbourhood_attention(q, k, v, rpb):
    B, S, H, d = q.shape
    rows = S // GRID_W
    kh = min(NA_KH, rows)
    r = jnp.arange(rows)
    row_start = jnp.clip(r - kh // 2, 0, rows - kh)
    row_idx = row_start[:, None] + jnp.arange(kh)[None, :]
    c = jnp.arange(GRID_W)
    col_start = jnp.clip(c - NA_KW // 2, 0, GRID_W - NA_KW)
    col_ok = (c[None, :] >= col_start[:, None]) & (c[None, :] < col_start[:, None] + NA_KW)

    qg = q.reshape(B, rows, GRID_W, H, d)
    kg = k.reshape(B, rows, GRID_W, H, d)[:, row_idx]
    vg = v.reshape(B, rows, GRID_W, H, d)[:, row_idx]
    s = jnp.einsum('brqhd,brikhd->brhqik', qg, kg).astype(jnp.float32) * (d ** -0.5)

    dy = row_idx - r[:, None] + (NA_KH - 1)
    dx = jnp.clip(c[None, :] - c[:, None], -(NA_KW - 1), NA_KW - 1) + (NA_KW - 1)
    bias = rpb.astype(jnp.float32)[:, dy][..., dx]
    bias = bias.transpose(1, 0, 3, 2, 4)
    s = jnp.where(col_ok[:, None, :], s + bias[None], -jnp.inf)
    p = jax.nn.softmax(s.reshape(B, rows, H, GRID_W, kh * GRID_W), axis=-1)
    p = p.reshape(B, rows, H, GRID_W, kh, GRID_W).astype(v.dtype)
    out = jnp.einsum('brhqik,brikhd->brqhd', p, vg)
    return out.reshape(B, S, H * d)


def setup_inputs(seed: int = 0) -> dict:
    key = jax.random.key(seed)
    ks = jax.random.split(key, 16)
    f32 = jnp.float32

    def w(k, shape, fan_in):
        return jax.random.normal(k, shape, f32) * fan_in ** -0.5

    def gain(k, shape):
        return 1.0 + 0.01 * jax.random.normal(k, shape, f32)

    return {
        "x": jax.random.normal(ks[0], (BATCH, SEQ, D_MODEL), f32),
        "norm_mix": gain(ks[1], (DEPTH, D_MODEL)),
        "w_in": w(ks[2], (DEPTH, D_MODEL, IN_TOTAL), D_MODEL),
        "norm_qa": gain(ks[3], (DEPTH, Q_LORA)),
        "w_uq": w(ks[4], (DEPTH, Q_LORA, MLA_HEADS * (QK_NOPE + QK_ROPE)), Q_LORA),
        "norm_kva": gain(ks[5], (DEPTH, KV_LORA)),
        "w_ukv": w(ks[6], (DEPTH, KV_LORA, MLA_HEADS * (QK_NOPE + V_HEAD)), KV_LORA),
        "rpb": 0.02 * jax.random.normal(ks[7], (DEPTH, NA_HEADS, 2 * NA_KH - 1, 2 * NA_KW - 1), f32),
        "w_o_mla": w(ks[8], (DEPTH, MLA_W, D_MODEL), MLA_W),
        "w_o_na": w(ks[9], (DEPTH, NA_W, D_MODEL), NA_W),
        "w_out": w(ks[10], (DEPTH, D_MODEL, D_MODEL), D_MODEL),
        "norm_mlp": gain(ks[11], (DEPTH, D_MODEL)),
        "w_ff1": w(ks[12], (DEPTH, D_MODEL, D_FF), D_MODEL),
        "w_ff2": w(ks[13], (DEPTH, D_FF, D_MODEL), D_FF),
        "norm_final": gain(ks[14], (D_MODEL,)),
    }


def reference(x, norm_mix, w_in, norm_qa, w_uq, norm_kva, w_ukv, rpb, w_o_mla, w_o_na,
              w_out, norm_mlp, w_ff1, w_ff2, norm_final):
    B, S, _ = x.shape
    pos = jnp.arange(S, dtype=jnp.float32)
    inv_freq = 1.0 / (ROPE_THETA ** (jnp.arange(0, QK_ROPE, 2, dtype=jnp.float32) / QK_ROPE))
    ang = pos[:, None] * inv_freq[None, :]
    cos = jnp.cos(ang).astype(x.dtype)
    sin = jnp.sin(ang).astype(x.dtype)

    for l in range(DEPTH):
        u = rmsnorm(x, norm_mix[l])
        proj = u @ w_in[l]
        c_q, c_kv, k_pe, q_na, k_na, v_na, gate_a, gate_b = jnp.split(proj, IN_SPLITS, axis=-1)

        q = (rmsnorm(c_q, norm_qa[l]) @ w_uq[l]).reshape(B, S, MLA_HEADS, QK_NOPE + QK_ROPE)
        kv = (rmsnorm(c_kv, norm_kva[l]) @ w_ukv[l]).reshape(B, S, MLA_HEADS, QK_NOPE + V_HEAD)
        q_nope, q_pe = q[..., :QK_NOPE], q[..., QK_NOPE:]
        k_nope, v = kv[..., :QK_NOPE], kv[..., QK_NOPE:]
        q_pe = rope(q_pe, cos[:, None, :], sin[:, None, :])
        k_pe = rope(k_pe, cos, sin)
        y_a = mla_attention(q_nope, q_pe, k_nope, k_pe, v) @ w_o_mla[l]

        hs = (B, S, NA_HEADS, NA_HEAD_DIM)
        y_b = neighbourhood_attention(q_na.reshape(hs), k_na.reshape(hs), v_na.reshape(hs), rpb[l]) @ w_o_na[l]

        merged = jax.nn.sigmoid(gate_a) * y_a + jax.nn.sigmoid(gate_b) * y_b
        x = x + merged @ w_out[l]

        h = rmsnorm(x, norm_mlp[l]) @ w_ff1[l]
        x = x + jnp.square(jax.nn.relu(h)) @ w_ff2[l]

    return rmsnorm(x, norm_final)
```

```cpp
#include <hip/hip_runtime.h>
#include <hip/hip_cooperative_groups.h>
#include <cstdio>
#include <cstdint>
#include <cmath>
namespace cg = cooperative_groups;

constexpr int S = 8192, DM = 2048, DEPTH = 4, NH = 8, DQK = 192, DFF = 8192, INT = 8256;
constexpr float EPS = 1e-6f;
typedef unsigned short bf16_t;
typedef _Float16 f16_t;

constexpr size_t MiB = 1u << 20;
constexpr size_t OFF_CS = 0;
constexpr size_t OFF_SSQ = 2 * MiB;
constexpr size_t OFF_KPER = 3 * MiB;
constexpr size_t OFF_QPER = 5 * MiB;
constexpr size_t OFF_U = 24 * MiB;
constexpr size_t OFF_CQ = 56 * MiB;
constexpr size_t OFF_CKV = 64 * MiB;
constexpr size_t OFF_QNA = 72 * MiB, OFF_KNA = 88 * MiB, OFF_VNA = 104 * MiB;
constexpr size_t OFF_GA = 120 * MiB, OFF_GB = 152 * MiB;
constexpr size_t OFF_QM = 184 * MiB, OFF_KM = 208 * MiB;
constexpr size_t OFF_VM = 232 * MiB;
constexpr size_t OFF_ATA = 248 * MiB, OFF_ATB = 264 * MiB;
constexpr size_t OFF_T = 280 * MiB;
constexpr size_t OFF_MRG = 344 * MiB;
constexpr size_t OFF_H = 376 * MiB;
constexpr size_t OFF_W = 504 * MiB;
constexpr size_t WL_IN = 0, WL_UQ = 33 * MiB, WL_UKV = WL_UQ + 3 * MiB / 2, WL_OA = WL_UKV + 2 * MiB, WL_OB = WL_OA + 4 * MiB,
                 WL_OUT = WL_OB + 4 * MiB, WL_FF1 = WL_OUT + 8 * MiB, WL_FF2 = WL_FF1 + 32 * MiB, WL_STRIDE = 117 * MiB;
constexpr size_t WS_END = OFF_W + 4 * WL_STRIDE;
constexpr int NIN_PAD = 8448;

__device__ __forceinline__ float bf2f(bf16_t v) { return __uint_as_float((unsigned)v << 16); }
__device__ __forceinline__ bf16_t f2bf(float f) { unsigned u = __float_as_uint(f); return (bf16_t)((u + 0x7fffu + ((u >> 16) & 1u)) >> 16); }
__device__ __forceinline__ unsigned pk2(float lo, float hi) { return (unsigned)f2bf(lo) | ((unsigned)f2bf(hi) << 16); }
__device__ __forceinline__ float sigmoidf(float v) { return __builtin_amdgcn_rcpf(1.0f + __expf(-v)); }

struct Args {
    const float* in[15];
    float* out;
    unsigned char* ws;
    int ph_lo, ph_hi;
};
__device__ __forceinline__ float inv_freq(int i) { double p = 1.0; for (int k = 0; k < i; ++k) p *= 0.7498942093324559; return (float)p; }
enum { I_X = 0, I_NMIX, I_WIN, I_NQA, I_WUQ, I_NKVA, I_WUKV, I_RPB, I_WOA, I_WOB, I_WOUT, I_NMLP, I_WFF1, I_WFF2, I_NFIN };

__device__ __forceinline__ void sincos_acc(float a, float& c, float& s) {
    const double x = (double)a;
    const double k = rint(x * 0.15915494309189535);
    double r = fma(-k, 6.283185307179586, x); r = fma(-k, 2.4492935982947064e-16, r);
    const double q = rint(r * 0.6366197723675814);
    double t = fma(-q, 1.5707963267948966, r); t = fma(-q, 6.123233995736766e-17, t);
    const int qi = ((int)q) & 3;
    const double t2 = t * t;
    const double sp = t * (1.0 + t2 * (-1.0 / 6 + t2 * (1.0 / 120 + t2 * (-1.0 / 5040 + t2 * (1.0 / 362880 + t2 * (-1.0 / 39916800 + t2 * (1.0 / 6227020800.0)))))));
    const double cp = 1.0 + t2 * (-0.5 + t2 * (1.0 / 24 + t2 * (-1.0 / 720 + t2 * (1.0 / 40320 + t2 * (-1.0 / 3628800 + t2 * (1.0 / 479001600 + t2 * (-1.0 / 87178291200.0)))))));
    double ss, cc;
    if (qi == 0) { ss = sp; cc = cp; } else if (qi == 1) { ss = cp; cc = -sp; } else if (qi == 2) { ss = -sp; cc = -cp; } else { ss = -cp; cc = sp; }
    c = (float)cc; s = (float)ss;
}
namespace nv {
__global__ __launch_bounds__(256) void k_cs(float2* CS, Args a) {
    const int idx = blockIdx.x * 256 + threadIdx.x;
    if (idx >= S * 32) return;
    const int pos = idx >> 5, i = idx & 31;
    const float ang = (float)pos * inv_freq(i);
    float c, s; sincos_acc(ang, c, s);
    CS[idx] = make_float2(c, s);
}
template <bool F32OUT>
__global__ __launch_bounds__(256) void k_norm(const float* X, const float* g, bf16_t* Ub, float* Of) {
    const int row = (blockIdx.x * 256 + threadIdx.x) >> 6, lane = threadIdx.x & 63;
    if (row >= S) return;
    const float4* xr = (const float4*)(X + (size_t)row * DM);
    float4 v[8]; float ss = 0.f;
#pragma unroll
    for (int j = 0; j < 8; ++j) { v[j] = xr[lane + 64 * j]; ss += v[j].x * v[j].x + v[j].y * v[j].y + v[j].z * v[j].z + v[j].w * v[j].w; }
#pragma unroll
    for (int o = 1; o < 64; o <<= 1) ss += __shfl_xor(ss, o);
    const float rinv = rsqrtf(ss * (1.0f / DM) + EPS);
    const float4* gr = (const float4*)g;
#pragma unroll
    for (int j = 0; j < 8; ++j) {
        const float4 gg = gr[lane + 64 * j];
        const float o0 = v[j].x * rinv * gg.x, o1 = v[j].y * rinv * gg.y, o2 = v[j].z * rinv * gg.z, o3 = v[j].w * rinv * gg.w;
        if (F32OUT) ((float4*)(Of + (size_t)row * DM))[lane + 64 * j] = make_float4(o0, o1, o2, o3);
        else ((uint2*)(Ub + (size_t)row * DM))[lane + 64 * j] = make_uint2(pk2(o0, o1), pk2(o2, o3));
    }
}
__global__ __launch_bounds__(256) void k_ssq(const bf16_t* CQ, const bf16_t* CKV, float* SSQ) {
    const int row = (blockIdx.x * 256 + threadIdx.x) >> 6, lane = threadIdx.x & 63;
    if (row >= S) return;
    float a = 0.f, b = 0.f;
    for (int j = lane; j < 512; j += 64) { const float x = bf2f(CQ[(size_t)row * 512 + j]), y = bf2f(CKV[(size_t)row * 512 + j]); a += x * x; b += y * y; }
#pragma unroll
    for (int o = 1; o < 64; o <<= 1) { a += __shfl_xor(a, o); b += __shfl_xor(b, o); }
    if (lane < 16) SSQ[(size_t)row * 16 + lane] = (lane == 0) ? a : (lane == 8 ? b : 0.f);
}
__device__ __forceinline__ float rinv_from_ssq(const float* SSQ, int row, int off) {
    const float4 a = *(const float4*)(SSQ + (size_t)row * 16 + off), b = *(const float4*)(SSQ + (size_t)row * 16 + off + 4);
    const float s = ((a.x + a.y) + (a.z + a.w)) + ((b.x + b.y) + (b.z + b.w));
    return rsqrtf(s * (1.0f / 512.0f) + EPS);
}
struct EpiIn { bf16_t *CQ, *CKV, *QNA, *KNA, *VNA; f16_t *GA, *GB; float* KPER;
    __device__ __forceinline__ void operator()(int row, int col, float v) const {
        if (col < 512) CQ[(size_t)row * 512 + col] = f2bf(v);
        else if (col < 1024) CKV[(size_t)row * 512 + col - 512] = f2bf(v);
        else if (col < 1088) KPER[(size_t)row * 64 + col - 1024] = v;
        else if (col < 2112) QNA[(size_t)row * 1024 + col - 1088] = f2bf(v);
        else if (col < 3136) KNA[(size_t)row * 1024 + col - 2112] = f2bf(v);
        else if (col < 4160) VNA[(size_t)row * 1024 + col - 3136] = f2bf(v);
        else if (col < 6208) GA[(size_t)row * 2048 + col - 4160] = (f16_t)sigmoidf(v);
        else GB[(size_t)row * 2048 + col - 6208] = (f16_t)sigmoidf(v);
    } };
struct EpiQ { bf16_t* QM; float* QPER; const float* SSQ;
    __device__ __forceinline__ void operator()(int row, int col, float v) const {
        v *= rinv_from_ssq(SSQ, row, 0); const int h = col / 192, j = col % 192;
        if (j < 128) QM[(size_t)row * 1536 + col] = f2bf(v); else QPER[(size_t)row * 512 + h * 64 + j - 128] = v;
    } };
struct EpiKV { bf16_t *KM, *VM; const float* SSQ;
    __device__ __forceinline__ void operator()(int row, int col, float v) const {
        v *= rinv_from_ssq(SSQ, row, 8); const int h = col / 256, j = col % 256;
        if (j < 128) KM[(size_t)row * 1536 + h * 192 + j] = f2bf(v); else VM[(size_t)row * 1024 + h * 128 + j - 128] = f2bf(v);
    } };
struct EpiOA { float* T; const f16_t* GA;
    __device__ __forceinline__ void operator()(int row, int col, float v) const { const size_t i = (size_t)row * 2048 + col; T[i] = (float)GA[i] * v; } };
struct EpiOB { const float* T; const f16_t* GB; bf16_t* MRG;
    __device__ __forceinline__ void operator()(int row, int col, float v) const { const size_t i = (size_t)row * 2048 + col; MRG[i] = f2bf(T[i] + (float)GB[i] * v); } };
struct EpiRes { const float* XI; float* XO;
    __device__ __forceinline__ void operator()(int row, int col, float v) const { const size_t i = (size_t)row * 2048 + col; XO[i] = XI[i] + v; } };
struct EpiFF1 { bf16_t* H;
    __device__ __forceinline__ void operator()(int row, int col, float v) const { const float r = v > 0.f ? v : 0.f; H[(size_t)row * DFF + col] = f2bf(r * r); } };

template <class Epi>
__global__ __launch_bounds__(256) void k_gemm(const bf16_t* A, int lda, const float* W, int ldw, const float* gain, int N, int K, Epi E) {
    __shared__ float As[16][132]; __shared__ float Bs[16][132];
    const int t = threadIdx.x, bm = blockIdx.y * 128, bn = blockIdx.x * 128, ty = t >> 4, tx = t & 15;
    float acc[8][8];
#pragma unroll
    for (int i = 0; i < 8; ++i)
#pragma unroll
        for (int j = 0; j < 8; ++j) acc[i][j] = 0.f;
    for (int k0 = 0; k0 < K; k0 += 16) {
        { const int r = t >> 1, kk = (t & 1) * 8; const uint4 v = *(const uint4*)(A + (size_t)(bm + r) * lda + k0 + kk);
          const unsigned w[4] = {v.x, v.y, v.z, v.w};
#pragma unroll
          for (int i = 0; i < 4; ++i) { float lo = __uint_as_float(w[i] << 16), hi = __uint_as_float(w[i] & 0xffff0000u);
              if (gain) { lo *= gain[k0 + kk + 2 * i]; hi *= gain[k0 + kk + 2 * i + 1]; }
              As[kk + 2 * i][r] = lo; As[kk + 2 * i + 1][r] = hi; } }
#pragma unroll
        for (int i = 0; i < 2; ++i) { const int k = (t >> 5) + 8 * i, n = (t & 31) * 4;
            float4 v = make_float4(0.f, 0.f, 0.f, 0.f); if (bn + n < N) v = *(const float4*)(W + (size_t)(k0 + k) * ldw + bn + n);
            *(float4*)&Bs[k][n] = v; }
        __syncthreads();
#pragma unroll
        for (int kk = 0; kk < 16; ++kk) {
            float a[8], b[8];
            const float4 a0 = *(const float4*)&As[kk][ty * 8], a1 = *(const float4*)&As[kk][ty * 8 + 4];
            const float4 b0 = *(const float4*)&Bs[kk][tx * 8], b1 = *(const float4*)&Bs[kk][tx * 8 + 4];
            a[0] = a0.x; a[1] = a0.y; a[2] = a0.z; a[3] = a0.w; a[4] = a1.x; a[5] = a1.y; a[6] = a1.z; a[7] = a1.w;
            b[0] = b0.x; b[1] = b0.y; b[2] = b0.z; b[3] = b0.w; b[4] = b1.x; b[5] = b1.y; b[6] = b1.z; b[7] = b1.w;
#pragma unroll
            for (int i = 0; i < 8; ++i)
#pragma unroll
                for (int j = 0; j < 8; ++j) acc[i][j] = fmaf(a[i], b[j], acc[i][j]);
        }
        __syncthreads();
    }
#pragma unroll
    for (int i = 0; i < 8; ++i)
#pragma unroll
        for (int j = 0; j < 8; ++j) { const int row = bm + ty * 8 + i, col = bn + tx * 8 + j; if (col < N) E(row, col, acc[i][j]); }
}
template <bool DOK, bool DOQ>
__global__ __launch_bounds__(256) void k_rope(const float2* CS, const float* KPER, const float* QPER, bf16_t* KM, bf16_t* QM) {
    const int idx = blockIdx.x * 256 + threadIdx.x; if (idx >= S * 32) return;
    const int row = idx >> 5, i = idx & 31; const float2 cs = CS[idx];
    if (DOK) { const float x1 = KPER[(size_t)row * 64 + i], x2 = KPER[(size_t)row * 64 + 32 + i];
      const bf16_t o1 = f2bf(x1 * cs.x - x2 * cs.y), o2 = f2bf(x2 * cs.x + x1 * cs.y);
      for (int h = 0; h < 8; ++h) { KM[(size_t)row * 1536 + h * 192 + 128 + i] = o1; KM[(size_t)row * 1536 + h * 192 + 160 + i] = o2; } }
    if (DOQ) for (int h = 0; h < 8; ++h) { const float x1 = QPER[(size_t)row * 512 + h * 64 + i], x2 = QPER[(size_t)row * 512 + h * 64 + 32 + i];
        QM[(size_t)row * 1536 + h * 192 + 128 + i] = f2bf(x1 * cs.x - x2 * cs.y); QM[(size_t)row * 1536 + h * 192 + 160 + i] = f2bf(x2 * cs.x + x1 * cs.y); }
}
template <bool NA>
__global__ __launch_bounds__(256) void k_attn(const bf16_t* Q, const bf16_t* Kb, const bf16_t* Vb, bf16_t* O, const float* rpb) {
    constexpr int DQ = NA ? 128 : 192, PER = DQ / 64, LDQ = NA ? 1024 : 1536;
    const int wave = (blockIdx.x * 256 + threadIdx.x) >> 6, lane = threadIdx.x & 63;
    const int q = wave >> 3, h = wave & 7;
    const float scale = NA ? 0.08838834764831845f : 0.07216878364870323f;
    float qv[PER];
#pragma unroll
    for (int i = 0; i < PER; ++i) qv[i] = bf2f(Q[(size_t)q * LDQ + h * DQ + lane * PER + i]);
    float m = -1e30f, l = 0.f, o0 = 0.f, o1 = 0.f;
    const int r = q >> 6, c = q & 63;
    const int rs = min(max(r - 4, 0), 120), cs = min(max(c - 8, 0), 48);
    const int nkeys = NA ? 128 : S;
    for (int kk = 0; kk < nkeys; ++kk) {
        int key = kk; float bias = 0.f;
        if (NA) { const int i = kk >> 4, kc = cs + (kk & 15), kr = rs + i; key = kr * 64 + kc;
            const int dy = kr - r + 7, dx = min(max(kc - c, -15), 15) + 15; bias = rpb[h * 465 + dy * 31 + dx]; }
        float s = 0.f;
#pragma unroll
        for (int i = 0; i < PER; ++i) s += qv[i] * bf2f(Kb[(size_t)key * LDQ + h * DQ + lane * PER + i]);
#pragma unroll
        for (int o = 1; o < 64; o <<= 1) s += __shfl_xor(s, o);
        s = s * scale + bias;
        const float mn = fmaxf(m, s), al = __expf(m - mn), p = __expf(s - mn);
        const unsigned vv = *(const unsigned*)(Vb + (size_t)key * 1024 + h * 128 + lane * 2);
        l = l * al + p; o0 = o0 * al + p * __uint_as_float(vv << 16); o1 = o1 * al + p * __uint_as_float(vv & 0xffff0000u); m = mn;
    }
    const float il = 1.0f / l;
    *(unsigned*)(O + (size_t)q * 1024 + h * 128 + lane * 2) = pk2(o0 * il, o1 * il);
}
}
static void fill_args(Args& a, void* const* d_in, void* d_out, void* d_ws) {
    for (int i = 0; i < 15; ++i) a.in[i] = (const float*)d_in[i];
    a.out = (float*)d_out; a.ws = (unsigned char*)d_ws;
    a.ph_lo = 0; a.ph_hi = 0;
}
struct Bufs { float2* CS; float *SSQ, *KPER, *QPER, *T; bf16_t *U, *CQ, *CKV, *QNA, *KNA, *VNA, *QM, *KM, *VM, *ATA, *ATB, *MRG, *H; f16_t *GA, *GB; };
static Bufs get_bufs(unsigned char* ws) {
    Bufs b; b.CS = (float2*)(ws + OFF_CS); b.SSQ = (float*)(ws + OFF_SSQ); b.KPER = (float*)(ws + OFF_KPER); b.QPER = (float*)(ws + OFF_QPER); b.T = (float*)(ws + OFF_T);
    b.U = (bf16_t*)(ws + OFF_U); b.CQ = (bf16_t*)(ws + OFF_CQ); b.CKV = (bf16_t*)(ws + OFF_CKV); b.QNA = (bf16_t*)(ws + OFF_QNA); b.KNA = (bf16_t*)(ws + OFF_KNA); b.VNA = (bf16_t*)(ws + OFF_VNA);
    b.QM = (bf16_t*)(ws + OFF_QM); b.KM = (bf16_t*)(ws + OFF_KM); b.VM = (bf16_t*)(ws + OFF_VM); b.ATA = (bf16_t*)(ws + OFF_ATA); b.ATB = (bf16_t*)(ws + OFF_ATB);
    b.MRG = (bf16_t*)(ws + OFF_MRG); b.H = (bf16_t*)(ws + OFF_H); b.GA = (f16_t*)(ws + OFF_GA); b.GB = (f16_t*)(ws + OFF_GB); return b;
}
static void naive_stage(int l, int k, const Args& a, const Bufs& b, hipStream_t st) {
    const float* x = a.in[I_X]; float* out = a.out; const float* xin = (l == 0) ? x : out;
    const float* w_in = a.in[I_WIN] + (size_t)l * DM * INT; const float* w_uq = a.in[I_WUQ] + (size_t)l * 512 * 1536; const float* w_ukv = a.in[I_WUKV] + (size_t)l * 512 * 2048;
    const float* w_oa = a.in[I_WOA] + (size_t)l * 1024 * 2048; const float* w_ob = a.in[I_WOB] + (size_t)l * 1024 * 2048; const float* w_out = a.in[I_WOUT] + (size_t)l * 2048 * 2048;
    const float* w_ff1 = a.in[I_WFF1] + (size_t)l * DM * DFF; const float* w_ff2 = a.in[I_WFF2] + (size_t)l * DFF * DM;
    const dim3 blk(256); const int rowgrid = S * 64 / 256;
    switch (k) {
    case 0: nv::k_norm<false><<<rowgrid, blk, 0, st>>>(xin, a.in[I_NMIX] + (size_t)l * DM, b.U, nullptr); break;
    case 1: { nv::EpiIn e{b.CQ, b.CKV, b.QNA, b.KNA, b.VNA, b.GA, b.GB, b.KPER};
        nv::k_gemm<nv::EpiIn><<<dim3(65, 64), blk, 0, st>>>(b.U, 2048, w_in, INT, nullptr, INT, 2048, e);
        nv::k_ssq<<<rowgrid, blk, 0, st>>>(b.CQ, b.CKV, b.SSQ);
        nv::k_rope<true, false><<<S * 32 / 256, blk, 0, st>>>(b.CS, b.KPER, b.QPER, b.KM, b.QM); break; }
    case 2: { nv::EpiQ eq{b.QM, b.QPER, b.SSQ}; nv::k_gemm<nv::EpiQ><<<dim3(12, 64), blk, 0, st>>>(b.CQ, 512, w_uq, 1536, a.in[I_NQA] + (size_t)l * 512, 1536, 512, eq);
        nv::EpiKV ek{b.KM, b.VM, b.SSQ}; nv::k_gemm<nv::EpiKV><<<dim3(16, 64), blk, 0, st>>>(b.CKV, 512, w_ukv, 2048, a.in[I_NKVA] + (size_t)l * 512, 2048, 512, ek);
        nv::k_rope<false, true><<<S * 32 / 256, blk, 0, st>>>(b.CS, b.KPER, b.QPER, b.KM, b.QM); break; }
    case 3: nv::k_attn<false><<<S * 8 * 64 / 256, blk, 0, st>>>(b.QM, b.KM, b.VM, b.ATA, nullptr);
        nv::k_attn<true><<<S * 8 * 64 / 256, blk, 0, st>>>(b.QNA, b.KNA, b.VNA, b.ATB, a.in[I_RPB] + (size_t)l * 8 * 465); break;
    case 4: { nv::EpiOA ea{b.T, b.GA}; nv::k_gemm<nv::EpiOA><<<dim3(16, 64), blk, 0, st>>>(b.ATA, 1024, w_oa, 2048, nullptr, 2048, 1024, ea);
        nv::EpiOB eb{b.T, b.GB, b.MRG}; nv::k_gemm<nv::EpiOB><<<dim3(16, 64), blk, 0, st>>>(b.ATB, 1024, w_ob, 2048, nullptr, 2048, 1024, eb); break; }
    case 5: { nv::EpiRes e{xin, out}; nv::k_gemm<nv::EpiRes><<<dim3(16, 64), blk, 0, st>>>(b.MRG, 2048, w_out, 2048, nullptr, 2048, 2048, e); break; }
    case 6: nv::k_norm<false><<<rowgrid, blk, 0, st>>>(out, a.in[I_NMLP] + (size_t)l * DM, b.U, nullptr); break;
    case 7: { nv::EpiFF1 e{b.H}; nv::k_gemm<nv::EpiFF1><<<dim3(64, 64), blk, 0, st>>>(b.U, 2048, w_ff1, DFF, nullptr, DFF, 2048, e); break; }
    case 8: { nv::EpiRes e{out, out}; nv::k_gemm<nv::EpiRes><<<dim3(16, 64), blk, 0, st>>>(b.H, DFF, w_ff2, 2048, nullptr, 2048, DFF, e); break; }
    }
}
static void naive_prologue(const Args& a, const Bufs& b, hipStream_t st) { nv::k_cs<<<S * 32 / 256, 256, 0, st>>>(b.CS, a); }
static void naive_final(const Args& a, hipStream_t st) { nv::k_norm<true><<<S * 64 / 256, 256, 0, st>>>(a.out, a.in[I_NFIN], nullptr, a.out); }
#define LAS __attribute__((address_space(3)))
typedef short bf16x8 __attribute__((ext_vector_type(8)));
typedef float f32x4 __attribute__((ext_vector_type(4)));
typedef unsigned u32x4 __attribute__((ext_vector_type(4)));
typedef _Float16 f16x2 __attribute__((ext_vector_type(2)));
__device__ __forceinline__ unsigned cvt_pk_bf16(float lo, float hi) { unsigned r; asm volatile("v_cvt_pk_bf16_f32 %0, %1, %2" : "=v"(r) : "v"(lo), "v"(hi)); return r; }
__device__ __forceinline__ unsigned cvt_pk_f16(float lo, float hi) { f16x2 h = {(_Float16)lo, (_Float16)hi}; return __builtin_bit_cast(unsigned, h); }
__device__ __forceinline__ float2 unpk_f16(unsigned w) { f16x2 h = __builtin_bit_cast(f16x2, w); return make_float2((float)h.x, (float)h.y); }
namespace pg8 {
constexpr int BM = 256, BK = 64, HALF = 128, HTB = HALF * BK * 2, STAGE_BYTES = 8 * HTB, NXCD = 8, WGM = 4;
__host__ __device__ __forceinline__ int lds_byte(int r, int c) { const int st = (r >> 4) * 2 + (c >> 5), rr = r & 15, cc = c & 31, ob = rr * 64 + cc * 2; return st * 1024 + (ob ^ (((ob >> 9) & 1) << 5)); }
__host__ __device__ __forceinline__ void stage_rc(int b, int& R, int& C) { const int st = b / 1024, sb = b % 1024, swz = sb ^ (((sb >> 9) & 1) << 5); R = (st >> 1) * 16 + swz / 64; C = (st & 1) * 32 + (swz % 64) / 2; }
__host__ __device__ __forceinline__ int perm32(int rho) { const int n = rho >> 4, i = rho & 15; return 8 * (i >> 2) + 4 * n + (i & 3); }
struct Unit { int pm, pn, z; };
struct Gemm { const bf16_t* A0; const bf16_t* A1; const bf16_t* B0; const bf16_t* B1; int K; };
struct StaticOrder {
    int nM, nN, nwg, G, c;
    __device__ void init(int M, int N, int G_, int c_) { nM = M / BM; nN = N / BM; nwg = nM * nN; G = G_; c = c_; }
    __device__ bool next(int i, Unit& u) const {
        const long L = (long)i * G + c; if (L >= nwg) return false;
        int wgid = (int)L; { const int q = nwg / NXCD, r = nwg % NXCD, xcd = wgid % NXCD, off = wgid / NXCD; wgid = (xcd < r ? xcd * (q + 1) : r * (q + 1) + (xcd - r) * q) + off; }
        const int nig = WGM * nN, gid = wgid / nig, fm = gid * WGM, gsz = (nM - fm) < WGM ? (nM - fm) : WGM;
        u.pm = fm + ((wgid % nig) % gsz); u.pn = (wgid % nig) / gsz; u.z = 0; return true;
    }
};
struct SchedQKV { StaticOrder so;
    __device__ void init(int G, int c) { so.init(S, 14 * 256, G, c); }
    __device__ bool next(int i, Unit& u) const { if (!so.next(i, u)) return false; if (u.pn >= 6) { u.pn -= 6; u.z = 1; } return true; } };
struct SchedO { StaticOrder so;
    __device__ void init(int G, int c) { so.init(S, 2048, G, c); }
    __device__ bool next(int i, Unit& u) const { if (!so.next(i >> 1, u)) return false; u.z = i & 1; return true; } };

template <class Epi, class Sched, bool ALIGN_EPI = true, bool SP2 = true>
__device__ __forceinline__ void gemm_phase(LAS unsigned char* lds, const Gemm g, const Sched& Sc, const Epi& E) {
    int tid_ = threadIdx.x; asm volatile("" : "+v"(tid_));
    const int tid = tid_, wid = __builtin_amdgcn_readfirstlane(tid >> 6), lane = tid & 63, wr = wid >> 2, wc = wid & 3, fr = lane & 15, fq = lane >> 4;
    const int K = g.K, nt = K / BK;
    unsigned voffA[2], voffB[2];
#pragma unroll
    for (int i = 0; i < 2; ++i) { int R, C; stage_rc(tid * 16 + i * 8192, R, C); const int Rb = Epi::PERM ? ((R & ~31) + perm32(R & 31)) : R;
        voffA[i] = (unsigned)(R * K + C) * 2u; voffB[i] = (unsigned)(Rb * K + C) * 2u; }
    const size_t kstep = (size_t)(BK * 2);
    const size_t hstep = (size_t)HALF * K * 2;
    const size_t tstep = 2 * hstep;
    const unsigned ldsw = (unsigned)wid * 1024u;
    const int aoff = lds_byte(wr * 64 + fr, fq * 8), boff = lds_byte(wc * 32 + fr, fq * 8);
#define PG8_SA(b, h) (((b) * 2 + (h)) * HTB)
#define PG8_SB(b, h) ((4 + (b) * 2 + (h)) * HTB)
#define PG8_STAGE(bufoff, gbase, voff) do { _Pragma("unroll") for (int _i = 0; _i < 2; ++_i) \
        __builtin_amdgcn_global_load_lds((const unsigned*)((const char*)(gbase) + (voff)[_i]), (LAS unsigned*)(lds + (bufoff) + ldsw + _i * 8192), 16, 0, 0); } while (0)
#define PG8_LDA(dst, b, h) do { _Pragma("unroll") for (int m = 0; m < 4; ++m) _Pragma("unroll") for (int k = 0; k < 2; ++k) dst[m][k] = *(const LAS bf16x8*)(lds + PG8_SA(b, h) + aoff + m * 2048 + k * 1024); } while (0)
#define PG8_LDB(dst, b, h) do { _Pragma("unroll") for (int n = 0; n < 2; ++n) _Pragma("unroll") for (int k = 0; k < 2; ++k) dst[n][k] = *(const LAS bf16x8*)(lds + PG8_SB(b, h) + boff + n * 2048 + k * 1024); } while (0)
#define PG8_MMA(ai, bj, At, Bt) do { __builtin_amdgcn_s_setprio(1); _Pragma("unroll") for (int m = 0; m < 4; ++m) _Pragma("unroll") for (int n = 0; n < 2; ++n) _Pragma("unroll") for (int k = 0; k < 2; ++k) \
        acc[ai][bj][m][n] = __builtin_amdgcn_mfma_f32_16x16x32_bf16(Bt[n][k], At[m][k], acc[ai][bj][m][n], 0, 0, 0); __builtin_amdgcn_s_setprio(0); } while (0)
#define PG8_WAIT_V(n) asm volatile("s_waitcnt vmcnt(" #n ")" ::: "memory")
#define PG8_WAIT_L(n) asm volatile("s_waitcnt lgkmcnt(" #n ")" ::: "memory")
#define PG8_BAR __builtin_amdgcn_s_barrier()
#define PG8_SCHED __builtin_amdgcn_sched_barrier(0)
#define PG8_APTR(u) ((const char*)((u).z ? g.A1 : g.A0) + (size_t)(u).pm * tstep)
#define PG8_BPTR(u) ((const char*)((u).z ? g.B1 : g.B0) + (size_t)(u).pn * tstep)
    Unit cur, nxt; int ui = 0;
    if (!Sc.next(0, cur)) return;
    f32x4 acc[2][2][4][2];
#pragma unroll
    for (int a = 0; a < 2; ++a)
#pragma unroll
        for (int b = 0; b < 2; ++b)
#pragma unroll
            for (int m = 0; m < 4; ++m)
#pragma unroll
                for (int n = 0; n < 2; ++n) acc[a][b][m][n] = (f32x4){0.f, 0.f, 0.f, 0.f};
    bf16x8 At[4][2], B0[2][2], B1[2][2];
    const char* cA = PG8_APTR(cur); const char* cB = PG8_BPTR(cur);
    if constexpr (SP2) {
        PG8_STAGE(PG8_SB(0, 0), cB, voffB); PG8_STAGE(PG8_SB(0, 1), cB + hstep, voffB); PG8_STAGE(PG8_SA(0, 0), cA, voffA); PG8_STAGE(PG8_SA(0, 1), cA + hstep, voffA);
        if (wr == 1) PG8_BAR;
        PG8_WAIT_V(2); PG8_BAR;
        PG8_STAGE(PG8_SB(1, 0), cB + kstep, voffB); PG8_STAGE(PG8_SA(1, 0), cA + kstep, voffA); PG8_STAGE(PG8_SB(1, 1), cB + hstep + kstep, voffB);
        PG8_WAIT_V(6); PG8_BAR;
    } else {
        PG8_STAGE(PG8_SB(0, 0), cB, voffB); PG8_STAGE(PG8_SA(0, 0), cA, voffA); PG8_STAGE(PG8_SB(0, 1), cB + hstep, voffB); PG8_STAGE(PG8_SA(0, 1), cA + hstep, voffA);
        if (wr == 1) PG8_BAR;
        PG8_WAIT_V(4); PG8_BAR;
        PG8_STAGE(PG8_SB(1, 0), cB + kstep, voffB); PG8_STAGE(PG8_SA(1, 0), cA + kstep, voffA); PG8_STAGE(PG8_SB(1, 1), cB + hstep + kstep, voffB);
        PG8_WAIT_V(6); PG8_BAR;
    }
    for (;;) {
        const bool has_next = Sc.next(ui + 1, nxt);
        const char* nA = has_next ? PG8_APTR(nxt) : cA; const char* nB = has_next ? PG8_BPTR(nxt) : cB;
        for (int t = 0; t < nt; t += 2) {
            const bool last = (t == nt - 2);
            const char* a1 = cA + (size_t)(t + 1) * kstep;
            const char* a2 = last ? nA : cA + (size_t)(t + 2) * kstep; const char* b2 = last ? nB : cB + (size_t)(t + 2) * kstep;
            const char* a3 = a2 + kstep; const char* b3 = b2 + kstep;
            if constexpr (SP2) {
            PG8_LDB(B0, 0, 0); PG8_LDB(B1, 0, 1); PG8_SCHED; PG8_LDA(At, 0, 0); PG8_STAGE(PG8_SA(1, 1), a1 + hstep, voffA);
            PG8_WAIT_V(8); PG8_WAIT_L(0); PG8_BAR; PG8_MMA(0, 0, At, B0); PG8_MMA(0, 1, At, B1); PG8_BAR; PG8_SCHED;
            PG8_LDA(At, 0, 1); PG8_STAGE(PG8_SB(0, 0), b2, voffB); PG8_STAGE(PG8_SB(0, 1), b2 + hstep, voffB); PG8_STAGE(PG8_SA(0, 0), a2, voffA);
            PG8_WAIT_V(8); PG8_WAIT_L(0); PG8_BAR; PG8_MMA(1, 0, At, B0); PG8_MMA(1, 1, At, B1); PG8_BAR; PG8_SCHED;
            PG8_LDB(B0, 1, 0); PG8_LDB(B1, 1, 1); PG8_SCHED; PG8_LDA(At, 1, 0); PG8_STAGE(PG8_SA(0, 1), a2 + hstep, voffA);
            PG8_WAIT_V(8); PG8_WAIT_L(0); PG8_BAR; PG8_MMA(0, 0, At, B0); PG8_MMA(0, 1, At, B1); PG8_BAR; PG8_SCHED;
            PG8_LDA(At, 1, 1); PG8_STAGE(PG8_SB(1, 0), b3, voffB); PG8_STAGE(PG8_SB(1, 1), b3 + hstep, voffB); PG8_STAGE(PG8_SA(1, 0), a3, voffA);
            PG8_WAIT_V(8); PG8_WAIT_L(0); PG8_BAR; PG8_MMA(1, 0, At, B0); PG8_MMA(1, 1, At, B1); PG8_BAR; PG8_SCHED;
            } else {
            PG8_LDB(B0, 0, 0); PG8_SCHED; PG8_LDA(At, 0, 0); PG8_STAGE(PG8_SA(1, 1), a1 + hstep, voffA);
            PG8_WAIT_L(8); PG8_BAR; PG8_WAIT_L(0); PG8_MMA(0, 0, At, B0); PG8_BAR; PG8_SCHED;
            PG8_LDB(B1, 0, 1); PG8_STAGE(PG8_SB(0, 0), b2, voffB);
            PG8_BAR; PG8_WAIT_L(0); PG8_MMA(0, 1, At, B1); PG8_BAR;
            PG8_LDA(At, 0, 1); PG8_STAGE(PG8_SA(0, 0), a2, voffA);
            PG8_BAR; PG8_WAIT_L(0); PG8_MMA(1, 0, At, B0); PG8_BAR; PG8_SCHED;
            PG8_STAGE(PG8_SB(0, 1), b2 + hstep, voffB);
            PG8_WAIT_V(6); PG8_BAR; PG8_MMA(1, 1, At, B1); PG8_BAR;
            PG8_LDB(B0, 1, 0); PG8_SCHED; PG8_LDA(At, 1, 0); PG8_STAGE(PG8_SA(0, 1), a2 + hstep, voffA);
            PG8_WAIT_L(8); PG8_BAR; PG8_WAIT_L(0); PG8_MMA(0, 0, At, B0); PG8_BAR; PG8_SCHED;
            PG8_LDB(B1, 1, 1); PG8_STAGE(PG8_SB(1, 0), b3, voffB);
            PG8_BAR; PG8_WAIT_L(0); PG8_MMA(0, 1, At, B1); PG8_BAR;
            PG8_LDA(At, 1, 1); PG8_STAGE(PG8_SA(1, 0), a3, voffA);
            PG8_BAR; PG8_WAIT_L(0); PG8_MMA(1, 0, At, B0); PG8_BAR; PG8_SCHED;
            PG8_STAGE(PG8_SB(1, 1), b3 + hstep, voffB);
            PG8_WAIT_V(6); PG8_BAR; PG8_MMA(1, 1, At, B1); PG8_BAR;
            }
        }
        if constexpr (ALIGN_EPI) { if (wr == 0) PG8_BAR; }
        E(acc, cur, wr, wc, fr, fq);
        if (!has_next) break;
#pragma unroll
        for (int a = 0; a < 2; ++a)
#pragma unroll
            for (int b = 0; b < 2; ++b)
#pragma unroll
                for (int m = 0; m < 4; ++m)
#pragma unroll
                    for (int n = 0; n < 2; ++n) acc[a][b][m][n] = (f32x4){0.f, 0.f, 0.f, 0.f};
        cur = nxt; cA = nA; cB = nB; ++ui;
        if constexpr (ALIGN_EPI) { if (wr == 1) PG8_BAR; }
    }
    PG8_WAIT_V(0);
    if constexpr (!ALIGN_EPI) { if (wr == 0) PG8_BAR; }
    PG8_BAR;
#undef PG8_SA
#undef PG8_SB
#undef PG8_STAGE
#undef PG8_LDA
#undef PG8_LDB
#undef PG8_MMA
#undef PG8_WAIT_V
#undef PG8_WAIT_L
#undef PG8_BAR
#undef PG8_SCHED
#undef PG8_APTR
#undef PG8_BPTR
}

typedef const f32x4 (&AccRef)[2][2][4][2];
__device__ __forceinline__ u32x4 pack8_bf16(const f32x4 v0, const f32x4 v1) { u32x4 w; w.x = cvt_pk_bf16(v0[0], v0[1]); w.y = cvt_pk_bf16(v0[2], v0[3]); w.z = cvt_pk_bf16(v1[0], v1[1]); w.w = cvt_pk_bf16(v1[2], v1[3]); return w; }
__device__ __forceinline__ float rinv_ssq(const float* SSQ, int row, int off) {
    const f32x4 a = *(const f32x4*)(SSQ + (size_t)row * 16 + off), b = *(const f32x4*)(SSQ + (size_t)row * 16 + off + 4);
    const float s = ((a[0] + a[1]) + (a[2] + a[3])) + ((b[0] + b[1]) + (b[2] + b[3]));
    return rsqrtf(s * (1.0f / 512.0f) + EPS);
}
__device__ __forceinline__ void rope8(const float2* cs, const f32x4 a0, const f32x4 a1, const f32x4 b0, const f32x4 b1, float sc, u32x4& o1, u32x4& o2) {
    float r1[8], r2[8];
#pragma unroll
    for (int j = 0; j < 8; ++j) { const float2 c = cs[j]; const float x1 = (j < 4 ? a0[j & 3] : a1[j & 3]) * sc, x2 = (j < 4 ? b0[j & 3] : b1[j & 3]) * sc;
        r1[j] = x1 * c.x - x2 * c.y; r2[j] = x2 * c.x + x1 * c.y; }
    o1.x = cvt_pk_bf16(r1[0], r1[1]); o1.y = cvt_pk_bf16(r1[2], r1[3]); o1.z = cvt_pk_bf16(r1[4], r1[5]); o1.w = cvt_pk_bf16(r1[6], r1[7]);
    o2.x = cvt_pk_bf16(r2[0], r2[1]); o2.y = cvt_pk_bf16(r2[2], r2[3]); o2.z = cvt_pk_bf16(r2[4], r2[5]); o2.w = cvt_pk_bf16(r2[6], r2[7]);
}
struct EpiInF { static constexpr bool PERM = true;
    bf16_t *CQ, *CKV, *QNA, *KNA, *VNA, *KM; f16_t *GA, *GB; float *SSQ, *KPER; const float2* CS;
    __device__ __forceinline__ void operator()(AccRef acc, const Unit& u, int wr, int wc, int fr, int fq) const {
        const int pn = u.pn, row0 = u.pm * BM + wr * 64 + fr, cb = wc * 32 + 8 * fq;
        if (pn < 16) {
            bf16_t* base; int ld, c0;
            if (pn < 2) { base = CQ; ld = 512; c0 = pn * 256; } else if (pn < 4) { base = CKV; ld = 512; c0 = (pn - 2) * 256; }
            else if (pn < 8) { base = QNA; ld = 1024; c0 = (pn - 4) * 256; } else if (pn < 12) { base = KNA; ld = 1024; c0 = (pn - 8) * 256; } else { base = VNA; ld = 1024; c0 = (pn - 12) * 256; }
#pragma unroll
            for (int ai = 0; ai < 2; ++ai)
#pragma unroll
                for (int m = 0; m < 4; ++m) { const int row = row0 + ai * HALF + m * 16; float ss = 0.f;
#pragma unroll
                    for (int bj = 0; bj < 2; ++bj) { const f32x4 v0 = acc[ai][bj][m][0], v1 = acc[ai][bj][m][1];
                        *(u32x4*)(base + (size_t)row * ld + c0 + bj * HALF + cb) = pack8_bf16(v0, v1);
                        ss += (v0[0] * v0[0] + v0[1] * v0[1]) + (v0[2] * v0[2] + v0[3] * v0[3]) + (v1[0] * v1[0] + v1[1] * v1[1]) + (v1[2] * v1[2] + v1[3] * v1[3]); }
                    if (pn < 4) { ss += __shfl_xor(ss, 16); ss += __shfl_xor(ss, 32); if (fq == 0) SSQ[(size_t)row * 16 + pn * 4 + wc] = ss; } }
        } else if (pn < 32) {
            f16_t* base = pn < 24 ? GA : GB; const int c0 = (pn < 24 ? pn - 16 : pn - 24) * 256;
#pragma unroll
            for (int ai = 0; ai < 2; ++ai)
#pragma unroll
                for (int m = 0; m < 4; ++m) { const int row = row0 + ai * HALF + m * 16;
#pragma unroll
                    for (int bj = 0; bj < 2; ++bj) { const f32x4 v0 = acc[ai][bj][m][0], v1 = acc[ai][bj][m][1]; u32x4 w;
                        w.x = cvt_pk_f16(sigmoidf(v0[0]), sigmoidf(v0[1])); w.y = cvt_pk_f16(sigmoidf(v0[2]), sigmoidf(v0[3]));
                        w.z = cvt_pk_f16(sigmoidf(v1[0]), sigmoidf(v1[1])); w.w = cvt_pk_f16(sigmoidf(v1[2]), sigmoidf(v1[3]));
                        *(u32x4*)(base + (size_t)row * 2048 + c0 + bj * HALF + cb) = w; } }
        }
    } };
struct EpiQKVF { static constexpr bool PERM = true;
    bf16_t *QM, *KM, *VM; const float* SSQ; const float2* CS;
    __device__ __forceinline__ void operator()(AccRef acc, const Unit& u, int wr, int wc, int fr, int fq) const {
        const int pn = u.pn, z = u.z, row0 = u.pm * BM + wr * 64 + fr, cb = wc * 32 + 8 * fq;
#pragma unroll
        for (int ai = 0; ai < 2; ++ai)
#pragma unroll
            for (int m = 0; m < 4; ++m) { const int row = row0 + ai * HALF + m * 16; const float r = rinv_ssq(SSQ, row, z ? 8 : 0);
                if (z == 0 && pn >= 4) {
                    const int head = 4 * (pn - 4) + wc, i0 = 8 * fq; u32x4 o1, o2;
                    rope8(CS + (size_t)row * 32 + i0, acc[ai][0][m][0], acc[ai][0][m][1], acc[ai][1][m][0], acc[ai][1][m][1], r, o1, o2);
                    bf16_t* q = QM + (size_t)row * 1536 + head * 192 + 128 + i0; *(u32x4*)q = o1; *(u32x4*)(q + 32) = o2;
                } else {
#pragma unroll
                    for (int bj = 0; bj < 2; ++bj) { const f32x4 v0 = acc[ai][bj][m][0] * r, v1 = acc[ai][bj][m][1] * r; bf16_t* dst;
                        if (z == 0) dst = QM + (size_t)row * 1536 + (2 * pn + bj) * 192 + cb;
                        else if (pn < 4) dst = KM + (size_t)row * 1536 + (2 * pn + bj) * 192 + cb;
                        else dst = VM + (size_t)row * 1024 + (2 * (pn - 4) + bj) * 128 + cb;
                        *(u32x4*)dst = pack8_bf16(v0, v1); }
                } }
    } };
struct EpiOF { static constexpr bool PERM = true;
    float* T; const f16_t *GA, *GB; bf16_t* MRG;
    __device__ __forceinline__ void operator()(AccRef acc, const Unit& u, int wr, int wc, int fr, int fq) const {
        const int row0 = u.pm * BM + wr * 64 + fr, cb = u.pn * 256 + wc * 32 + 8 * fq;
#pragma unroll
        for (int ai = 0; ai < 2; ++ai)
#pragma unroll
            for (int m = 0; m < 4; ++m) { const int row = row0 + ai * HALF + m * 16;
#pragma unroll
                for (int bj = 0; bj < 2; ++bj) { const size_t idx = (size_t)row * 2048 + cb + bj * HALF;
                    const u32x4 gw = *(const u32x4*)((u.z ? GB : GA) + idx);
                    const float2 g0 = unpk_f16(gw.x), g1 = unpk_f16(gw.y), g2 = unpk_f16(gw.z), g3 = unpk_f16(gw.w);
                    f32x4 v0 = acc[ai][bj][m][0], v1 = acc[ai][bj][m][1];
                    v0[0] *= g0.x; v0[1] *= g0.y; v0[2] *= g1.x; v0[3] *= g1.y; v1[0] *= g2.x; v1[1] *= g2.y; v1[2] *= g3.x; v1[3] *= g3.y;
                    if (u.z == 0) { *(f32x4*)(T + idx) = v0; *(f32x4*)(T + idx + 4) = v1; }
                    else { v0 += *(const f32x4*)(T + idx); v1 += *(const f32x4*)(T + idx + 4); *(u32x4*)(MRG + idx) = pack8_bf16(v0, v1); } } }
    } };
struct EpiResF { static constexpr bool PERM = true;
    const float* XI; float* XO;
    __device__ __forceinline__ void operator()(AccRef acc, const Unit& u, int wr, int wc, int fr, int fq) const {
        const int row0 = u.pm * BM + wr * 64 + fr, cb = u.pn * 256 + wc * 32 + 8 * fq;
#pragma unroll
        for (int ai = 0; ai < 2; ++ai)
#pragma unroll
            for (int m = 0; m < 4; ++m) { const int row = row0 + ai * HALF + m * 16;
#pragma unroll
                for (int bj = 0; bj < 2; ++bj) { const size_t idx = (size_t)row * 2048 + cb + bj * HALF;
                    const f32x4 x0 = *(const f32x4*)(XI + idx), x1 = *(const f32x4*)(XI + idx + 4);
                    *(f32x4*)(XO + idx) = x0 + acc[ai][bj][m][0]; *(f32x4*)(XO + idx + 4) = x1 + acc[ai][bj][m][1]; } }
    } };
struct EpiFF1F { static constexpr bool PERM = true;
    bf16_t* H;
    __device__ __forceinline__ void operator()(AccRef acc, const Unit& u, int wr, int wc, int fr, int fq) const {
        const int row0 = u.pm * BM + wr * 64 + fr, cb = u.pn * 256 + wc * 32 + 8 * fq;
#pragma unroll
        for (int ai = 0; ai < 2; ++ai)
#pragma unroll
            for (int m = 0; m < 4; ++m) { const int row = row0 + ai * HALF + m * 16;
#pragma unroll
                for (int bj = 0; bj < 2; ++bj) { f32x4 v0 = acc[ai][bj][m][0], v1 = acc[ai][bj][m][1];
#pragma unroll
                    for (int j = 0; j < 4; ++j) { const float a = fmaxf(v0[j], 0.f), b = fmaxf(v1[j], 0.f); v0[j] = a * a; v1[j] = b * b; }
                    *(u32x4*)(H + (size_t)row * DFF + cb + bj * HALF) = pack8_bf16(v0, v1); } }
    } };
}
#ifndef ATT_PIPE
#define ATT_PIPE 0
#endif
namespace att {
typedef short s16x4 __attribute__((ext_vector_type(4)));
typedef float f32x16 __attribute__((ext_vector_type(16)));
constexpr int NW = 8, QBLK = 32, KVBLK = 64;
constexpr float THR = 8.f;
constexpr int SHM_V = KVBLK * 128 * 2;
#define SBAR() __builtin_amdgcn_sched_barrier(0)
#define KSWZ(row, colB, RB) ((row) * (RB) + ((colB) ^ (((row) & 7) << 4)))
__device__ __forceinline__ int crow(int r, int hi) { return (r & 3) + 8 * (r >> 2) + 4 * hi; }
template <int DQ> struct Cfg { static constexpr float SCALE = DQ == 192 ? 0.07216878364870323f : 0.08838834764831845f; static constexpr int RB = DQ * 2, SHM_K = KVBLK * DQ * 2; };

template <int DQ> __device__ __forceinline__ void partialSM(f32x16& p0, f32x16& p1, float& m_reg, float& mn, float& alpha) {
  constexpr float SCALE = Cfg<DQ>::SCALE, C = SCALE * 1.4426950408889634f;
  float pmax = p0[0];
#pragma unroll
  for (int r = 1; r < 16; ++r) pmax = fmaxf(pmax, p0[r]);
#pragma unroll
  for (int r = 0; r < 16; ++r) pmax = fmaxf(pmax, p1[r]);
  { auto rr = __builtin_amdgcn_permlane32_swap(__float_as_uint(pmax), __float_as_uint(pmax), false, false);
    pmax = fmaxf(__uint_as_float(rr[0]), __uint_as_float(rr[1])); }
  if (__builtin_expect(__all(pmax - m_reg <= THR / SCALE), 1)) { mn = m_reg; alpha = 1.f; }
  else { mn = fmaxf(m_reg, pmax); alpha = __builtin_amdgcn_exp2f((m_reg - mn) * C); m_reg = mn; }
  const float mnC = -mn * C;
#pragma unroll
  for (int r = 0; r < 16; ++r) p0[r] = fmaf(p0[r], C, mnC);
#pragma unroll
  for (int r = 0; r < 16; ++r) p1[r] = fmaf(p1[r], C, mnC);
#pragma unroll
  for (int r = 0; r < 16; ++r) p0[r] = __builtin_amdgcn_exp2f(p0[r]);
}
__device__ __forceinline__ void finishSM(f32x16& p0, f32x16& p1, float alpha, float& l_reg, bf16x8& pa0, bf16x8& pa1, bf16x8& pa2, bf16x8& pa3) {
#pragma unroll
  for (int r = 0; r < 16; ++r) p1[r] = __builtin_amdgcn_exp2f(p1[r]);
  float ps = 0;
#pragma unroll
  for (int r = 0; r < 16; ++r) ps += p0[r];
#pragma unroll
  for (int r = 0; r < 16; ++r) ps += p1[r];
  { auto rr = __builtin_amdgcn_permlane32_swap(__float_as_uint(ps), __float_as_uint(ps), false, false);
    ps = __uint_as_float(rr[0]) + __uint_as_float(rr[1]); }
  l_reg = l_reg * alpha + ps;
#define PK4(P, BASE, OUT) do { unsigned a0 = cvt_pk_bf16(P[BASE + 0], P[BASE + 1]), a1 = cvt_pk_bf16(P[BASE + 2], P[BASE + 3]);   \
    unsigned b0 = cvt_pk_bf16(P[BASE + 4], P[BASE + 5]), b1 = cvt_pk_bf16(P[BASE + 6], P[BASE + 7]);                              \
    auto r0 = __builtin_amdgcn_permlane32_swap(a0, b0, false, false); auto r1 = __builtin_amdgcn_permlane32_swap(a1, b1, false, false); \
    u32x4 w = {r0[0], r1[0], r0[1], r1[1]}; OUT = __builtin_bit_cast(bf16x8, w); } while (0)
  PK4(p0, 0, pa0); PK4(p0, 8, pa1); PK4(p1, 0, pa2); PK4(p1, 8, pa3);
#undef PK4
}
template <int DQ> __device__ __forceinline__ void qkt(f32x16& p0, f32x16& p1, const char* Ks, const bf16x8* qr, int r32, int hi) {
  constexpr int RB = Cfg<DQ>::RB;
  p0 = f32x16{}; p1 = f32x16{};
#pragma unroll
  for (int d0 = 0; d0 < DQ / 16; ++d0) { const int cb = (d0 * 16 + hi * 8) * 2;
    const bf16x8 b0 = *reinterpret_cast<const bf16x8*>(Ks + KSWZ(r32, cb, RB));
    const bf16x8 b1 = *reinterpret_cast<const bf16x8*>(Ks + KSWZ(32 + r32, cb, RB));
    p0 = __builtin_amdgcn_mfma_f32_32x32x16_bf16(b0, qr[d0], p0, 0, 0, 0);
    p1 = __builtin_amdgcn_mfma_f32_32x32x16_bf16(b1, qr[d0], p1, 0, 0, 0); }
}
__device__ __forceinline__ int v_st(int k, int c) { const int kk = (k & ~0xC) | ((k & 4) << 1) | ((k & 8) >> 1); return ((kk >> 3) * 4 + (c >> 5)) * 512 + ((kk & 7) * 32 + (c & 31)) * 2; }
__device__ __forceinline__ int v_rd_base(int lane) { return ((lane & 3) << 3) | (((lane >> 2) & 3) << 6) | (((lane >> 4) & 1) << 5) | (((lane >> 5) & 1) << 8); }
constexpr int v_rd_off(int d0, int ks, int half) { return d0 * 512 + ks * 4096 + half * 2048; }
template <int OFF> __device__ __forceinline__ s16x4 tr_read(int vb) {
  s16x4 r; asm volatile("ds_read_b64_tr_b16 %0, %1 offset:%2" : "=&v"(r) : "v"(vb), "i"(OFF) : "memory"); return r;
}
template <int D0> __device__ __forceinline__ void pv_one(f32x16& od, int vb, bf16x8 pa0, bf16x8 pa1, bf16x8 pa2, bf16x8 pa3) {
  const s16x4 l0 = tr_read<v_rd_off(D0, 0, 0)>(vb), h0 = tr_read<v_rd_off(D0, 0, 1)>(vb), l1 = tr_read<v_rd_off(D0, 1, 0)>(vb), h1 = tr_read<v_rd_off(D0, 1, 1)>(vb);
  const s16x4 l2 = tr_read<v_rd_off(D0, 2, 0)>(vb), h2 = tr_read<v_rd_off(D0, 2, 1)>(vb), l3 = tr_read<v_rd_off(D0, 3, 0)>(vb), h3 = tr_read<v_rd_off(D0, 3, 1)>(vb);
  asm volatile("s_waitcnt lgkmcnt(0)" ::: "memory"); SBAR();
#define PK(L, H) (bf16x8){L[0], L[1], L[2], L[3], H[0], H[1], H[2], H[3]}
  od = __builtin_amdgcn_mfma_f32_32x32x16_bf16(pa0, PK(l0, h0), od, 0, 0, 0);
  od = __builtin_amdgcn_mfma_f32_32x32x16_bf16(pa1, PK(l1, h1), od, 0, 0, 0);
  od = __builtin_amdgcn_mfma_f32_32x32x16_bf16(pa2, PK(l2, h2), od, 0, 0, 0);
  od = __builtin_amdgcn_mfma_f32_32x32x16_bf16(pa3, PK(l3, h3), od, 0, 0, 0);
#undef PK
}
__device__ __forceinline__ void pv_d0(f32x16* o, int vb, bf16x8 pa0, bf16x8 pa1, bf16x8 pa2, bf16x8 pa3) {
  pv_one<0>(o[0], vb, pa0, pa1, pa2, pa3); pv_one<1>(o[1], vb, pa0, pa1, pa2, pa3); pv_one<2>(o[2], vb, pa0, pa1, pa2, pa3); pv_one<3>(o[3], vb, pa0, pa1, pa2, pa3);
}
struct NaCtx { const float* btab; int r, qc, cstart, wstart; };
__device__ __forceinline__ void na_mask(f32x16& p0, f32x16& p1, const NaCtx& c, int kr, int hi) {
  const bool inwin = (kr >= c.wstart) && (kr < c.wstart + 8);
  const int dy = min(max(kr - c.r + 7, 0), 14);
#pragma unroll
  for (int r = 0; r < 16; ++r) {
    const int kc0 = crow(r, hi), kc1 = kc0 + 32;
    const bool v0 = inwin && ((unsigned)(kc0 - c.cstart) < 16u), v1 = inwin && ((unsigned)(kc1 - c.cstart) < 16u);
    const int i0 = dy * 31 + min(max(kc0 - c.qc, -15), 15) + 15, i1 = dy * 31 + min(max(kc1 - c.qc, -15), 15) + 15;
    p0[r] = v0 ? p0[r] + c.btab[i0] : -1e30f; p1[r] = v1 ? p1[r] + c.btab[i1] : -1e30f;
  }
}
template <int DQ, bool NA>
__device__ __forceinline__ void attn_unit(const bf16_t* __restrict__ Qb, int ldq, const bf16_t* __restrict__ Kh, int ldk, const bf16_t* __restrict__ Vh, int ldv,
                                          bf16_t* __restrict__ Ob, int ldo, int NT, char* lds, const NaCtx nc, int krow0) {
  constexpr int RB = Cfg<DQ>::RB, SHM_K = Cfg<DQ>::SHM_K, NKC = DQ / 64, CPR = DQ / 8;
  int tid_ = threadIdx.x; asm volatile("" : "+v"(tid_));
  const int tid = tid_, wid = tid >> 6, lane = tid & 63, r32 = lane & 31, hi = lane >> 5;
  char* V_lds = lds; char* K_lds = lds + 2 * SHM_V;
  float* ws = (float*)(lds + 2 * SHM_V + 2 * SHM_K) + wid * 64; float* li_l = ws; float* al_l = ws + 32;
  float m_reg = -1e30f, l_reg = 0; f32x16 o[4] = {}; bf16x8 qr[DQ / 16];
  const bf16_t* Qw = Qb + (long)(wid * QBLK + r32) * ldq + hi * 8;
#pragma unroll
  for (int d0 = 0; d0 < DQ / 16; ++d0) qr[d0] = *reinterpret_cast<const bf16x8*>(Qw + d0 * 16);
  const int sr = tid >> 4, sc = (tid & 15) * 8, vst0 = v_st(sr, sc), vst1 = v_st(32 + sr, sc);
  int krow[NKC], kcol[NKC];
#pragma unroll
  for (int i = 0; i < NKC; ++i) { const int c = tid + 512 * i; krow[i] = c / CPR; kcol[i] = (c % CPR) * 8; }
  const int vb0 = (int)(uintptr_t)V_lds + v_rd_base(lane);
  bf16x8 vs0, vs1, ks[NKC];
#define SLOAD(k0) do { vs0 = *reinterpret_cast<const bf16x8*>(&Vh[(long)((k0) + sr) * ldv + sc]); vs1 = *reinterpret_cast<const bf16x8*>(&Vh[(long)((k0) + 32 + sr) * ldv + sc]); \
    _Pragma("unroll") for (int i_ = 0; i_ < NKC; ++i_) ks[i_] = *reinterpret_cast<const bf16x8*>(&Kh[(long)((k0) + krow[i_]) * ldk + kcol[i_]]); } while (0)
#define SWRITE(b) do { *(bf16x8*)(V_lds + (b) * SHM_V + vst0) = vs0; *(bf16x8*)(V_lds + (b) * SHM_V + vst1) = vs1; \
    _Pragma("unroll") for (int i_ = 0; i_ < NKC; ++i_) *(bf16x8*)(K_lds + (b) * SHM_K + KSWZ(krow[i_], kcol[i_] * 2, RB)) = ks[i_]; } while (0)
#define SWAIT() asm volatile("s_waitcnt vmcnt(0)" ::: "memory")
#define RESC(a) do { if (__any((a) < 1.f)) { if (hi == 0) al_l[r32] = (a); asm volatile("s_waitcnt lgkmcnt(0)" ::: "memory"); \
    _Pragma("unroll") for (int d = 0; d < 4; ++d) _Pragma("unroll") for (int r = 0; r < 16; ++r) o[d][r] *= al_l[crow(r, hi)]; } } while (0)
#define MASK(P0, P1, t) do { if (NA) na_mask(P0, P1, nc, krow0 + (t), hi); } while (0)
#if ATT_PIPE
  f32x16 pA0, pA1, pB0, pB1; float mnA, mnB, alA, alB; bf16x8 pa0, pa1, pa2, pa3;
  SLOAD(0); SWAIT(); SWRITE(0); __syncthreads();
  qkt<DQ>(pA0, pA1, K_lds, qr, r32, hi); MASK(pA0, pA1, 0); partialSM<DQ>(pA0, pA1, m_reg, mnA, alA);
  SLOAD(KVBLK);
  SWAIT(); SWRITE(1); __syncthreads();
  for (int j = 1; j + 1 < NT; j += 2) {
    SBAR(); qkt<DQ>(pB0, pB1, K_lds + SHM_K, qr, r32, hi); MASK(pB0, pB1, j);
    finishSM(pA0, pA1, alA, l_reg, pa0, pa1, pa2, pa3); SBAR();
    SLOAD((j + 1) * KVBLK); SBAR();
    pv_d0(o, vb0, pa0, pa1, pa2, pa3); partialSM<DQ>(pB0, pB1, m_reg, mnB, alB);
    __syncthreads(); SWAIT(); SWRITE(0);
    RESC(alB); __syncthreads();
    SBAR(); qkt<DQ>(pA0, pA1, K_lds, qr, r32, hi); MASK(pA0, pA1, j + 1);
    finishSM(pB0, pB1, alB, l_reg, pa0, pa1, pa2, pa3); SBAR();
    SLOAD((j + 2) * KVBLK); SBAR();
    pv_d0(o, vb0 + SHM_V, pa0, pa1, pa2, pa3); partialSM<DQ>(pA0, pA1, m_reg, mnA, alA);
    __syncthreads(); SWAIT(); SWRITE(1);
    RESC(alA); __syncthreads();
  }
  SBAR(); qkt<DQ>(pB0, pB1, K_lds + SHM_K, qr, r32, hi); MASK(pB0, pB1, NT - 1);
  finishSM(pA0, pA1, alA, l_reg, pa0, pa1, pa2, pa3); SBAR();
  pv_d0(o, vb0, pa0, pa1, pa2, pa3); partialSM<DQ>(pB0, pB1, m_reg, mnB, alB);
  __syncthreads(); RESC(alB);
  finishSM(pB0, pB1, alB, l_reg, pa0, pa1, pa2, pa3); SBAR();
  pv_d0(o, vb0 + SHM_V, pa0, pa1, pa2, pa3);
#else
  f32x16 p0, p1; float mn, al; bf16x8 pa0, pa1, pa2, pa3;
  SLOAD(0); SWAIT(); SWRITE(0); __syncthreads();
  for (int j = 0; j < NT; ++j) {
    const int b = j & 1;
    if (j + 1 < NT) SLOAD((j + 1) * KVBLK);
    SBAR();
    bool act = true;
    if (NA) { const int kr = krow0 + j; act = (kr >= nc.wstart) && (kr < nc.wstart + 8); }
    if (act) {
    qkt<DQ>(p0, p1, K_lds + b * SHM_K, qr, r32, hi); MASK(p0, p1, j);
    partialSM<DQ>(p0, p1, m_reg, mn, al);
    RESC(al);
    finishSM(p0, p1, al, l_reg, pa0, pa1, pa2, pa3); SBAR();
    pv_d0(o, vb0 + b * SHM_V, pa0, pa1, pa2, pa3);
    }
    if (j + 1 < NT) { SWAIT(); SWRITE(b ^ 1); }
    __syncthreads();
  }
#endif
  if (hi == 0) li_l[r32] = l_reg; asm volatile("s_waitcnt lgkmcnt(0)" ::: "memory");
  float rli[16];
#pragma unroll
  for (int r = 0; r < 16; ++r) rli[r] = __builtin_amdgcn_rcpf(li_l[crow(r, hi)]);
  bf16_t* Ow = Ob + (long)(wid * QBLK) * ldo;
  { bf16_t* stg = (bf16_t*)(lds + wid * 8192);
#pragma unroll
    for (int r = 0; r < 16; ++r) { const int orow = crow(r, hi);
#pragma unroll
      for (int d0 = 0; d0 < 4; ++d0) stg[orow * 128 + d0 * 32 + r32] = f2bf(o[d0][r] * rli[r]); }
    asm volatile("s_waitcnt lgkmcnt(0)" ::: "memory");
#pragma unroll
    for (int i = 0; i < 8; ++i) { const int row = i * 4 + (lane >> 4), ch = lane & 15; const u32x4 v = *(const u32x4*)(stg + row * 128 + ch * 8); *(u32x4*)(Ow + (long)row * ldo + ch * 8) = v; } }
  __syncthreads();
#undef SLOAD
#undef SWRITE
#undef SWAIT
#undef RESC
#undef MASK
}
#undef SBAR
}
namespace att2 {
using att::f32x16; using att::s16x4; using att::crow; using att::partialSM; using att::finishSM; using att::pv_d0; using att::v_rd_base; using att::NaCtx; using att::na_mask;
constexpr int KVBLK = 64, QBLK = 32, SLOTV = 16384;
#define SBAR() __builtin_amdgcn_sched_barrier(0)
template <int DQ> __device__ __forceinline__ void qkt(f32x16& p0, f32x16& p1, LAS const unsigned char* Ks, const int (&kb)[4], const bf16x8* qr) {
  p0 = f32x16{}; p1 = f32x16{};
  __builtin_amdgcn_s_setprio(1);
#pragma unroll
  for (int d0 = 0; d0 < DQ / 16; ++d0) {
    const bf16x8 b0 = *(LAS const bf16x8*)(Ks + kb[d0 & 3] + (d0 >> 2) * 8192);
    const bf16x8 b1 = *(LAS const bf16x8*)(Ks + kb[d0 & 3] + (d0 >> 2) * 8192 + 4096);
    p0 = __builtin_amdgcn_mfma_f32_32x32x16_bf16(b0, qr[d0], p0, 0, 0, 0);
    p1 = __builtin_amdgcn_mfma_f32_32x32x16_bf16(b1, qr[d0], p1, 0, 0, 0); }
  __builtin_amdgcn_s_setprio(0);
}
template <int DQ> struct L { static constexpr int SLOTK = KVBLK * DQ * 2, VBASE = 4 * SLOTK, WSOFF = VBASE + 3 * SLOTV, BYTES = WSOFF + 2048; };
template <int DQ, bool NA>
__device__ __forceinline__ void attn_unit(const bf16_t* __restrict__ Qb, int ldq, const bf16_t* __restrict__ Kh, int ldk, const bf16_t* __restrict__ Vh, int ldv,
                                          bf16_t* __restrict__ Ob, int ldo, int NT, LAS unsigned char* lds, const NaCtx nc, int krow0) {
  constexpr int SLOTK = L<DQ>::SLOTK, VBASE = L<DQ>::VBASE, NKC = DQ / 64;
  int tid_ = threadIdx.x; asm volatile("" : "+v"(tid_));
  const int tid = tid_, wid = __builtin_amdgcn_readfirstlane(tid >> 6), lane = tid & 63, r32 = lane & 31, hi = lane >> 5;
  LAS float* ws = (LAS float*)(lds + L<DQ>::WSOFF) + wid * 64; LAS float* li_l = ws; LAS float* al_l = ws + 32;
  float m_reg = -1e30f, l_reg = 0; f32x16 o[4] = {}; bf16x8 qr[DQ / 16];
  const bf16_t* Qw = Qb + (long)(wid * QBLK + r32) * ldq + hi * 8;
#pragma unroll
  for (int d0 = 0; d0 < DQ / 16; ++d0) qr[d0] = *reinterpret_cast<const bf16x8*>(Qw + d0 * 16);
  const int krow = 8 * wid + (lane >> 3), kch = (lane & 7) ^ ((krow >> 1) & 7);
  const bf16_t* kg0 = Kh + (long)krow * ldk + kch * 8;
  const int vkk = (wid >> 1) * 8 + ((lane & 31) >> 2), vkey = (vkk & ~0xC) | ((vkk & 4) << 1) | ((vkk & 8) >> 1), vcol = (2 * (wid & 1) + hi) * 32 + (lane & 3) * 8;
  const bf16_t* vg0 = Vh + (long)vkey * ldv + vcol;
  const unsigned wsl = (unsigned)wid * 1024u;
#define DMA_K(t, slot) do { const bf16_t* kg_ = kg0 + (long)(t) * KVBLK * ldk; \
    _Pragma("unroll") for (int i_ = 0; i_ < NKC; ++i_) __builtin_amdgcn_global_load_lds((const unsigned*)(kg_ + i_ * 64), (LAS unsigned*)(lds + (slot) * SLOTK + i_ * 8192 + wsl), 16, 0, 0); } while (0)
#define DMA_V(t, slot) do { const bf16_t* vg_ = vg0 + (long)(t) * KVBLK * ldv; \
    __builtin_amdgcn_global_load_lds((const unsigned*)(vg_), (LAS unsigned*)(lds + VBASE + (slot) * SLOTV + wsl), 16, 0, 0); \
    __builtin_amdgcn_global_load_lds((const unsigned*)(vg_ + 32 * (long)ldv), (LAS unsigned*)(lds + VBASE + (slot) * SLOTV + 8192 + wsl), 16, 0, 0); } while (0)
#define WAIT_BARN(full) do { if (full) { if (NKC == 3) asm volatile("s_waitcnt vmcnt(5) lgkmcnt(0)" ::: "memory"); else asm volatile("s_waitcnt vmcnt(4) lgkmcnt(0)" ::: "memory"); } \
    else asm volatile("s_waitcnt vmcnt(0) lgkmcnt(0)" ::: "memory"); __builtin_amdgcn_s_barrier(); asm volatile("" ::: "memory"); } while (0)
#define WAIT_BAR() do { asm volatile("s_waitcnt vmcnt(0) lgkmcnt(0)" ::: "memory"); __builtin_amdgcn_s_barrier(); asm volatile("" ::: "memory"); } while (0)
  int kb[4];
  { const int sw = (r32 >> 1) & 7, u = sw >> 1, t = hi ^ (sw & 1);
#pragma unroll
    for (int q = 0; q < 4; ++q) kb[q] = r32 * 128 + ((((q ^ u) * 2) + t) << 4); }
  const int vb0 = (int)(uintptr_t)(lds + VBASE) + v_rd_base(lane);
#define RESC(a) do { if (__any((a) < 1.f)) { if (hi == 0) al_l[r32] = (a); asm volatile("s_waitcnt lgkmcnt(0)" ::: "memory"); \
    _Pragma("unroll") for (int d = 0; d < 4; ++d) _Pragma("unroll") for (int r = 0; r < 16; ++r) o[d][r] *= al_l[crow(r, hi)]; } } while (0)
#define MASK(P0, P1, t) do { if (NA) na_mask(P0, P1, nc, krow0 + (t), hi); } while (0)
#define NEXT3(s) ((s) == 2 ? 0 : (s) + 1)
  f32x16 pA0, pA1, pB0, pB1; float mnA, mnB, alA, alB; bf16x8 pa0, pa1, pa2, pa3;
  DMA_K(0, 0); DMA_K(1, 1); DMA_V(0, 0); WAIT_BAR();
  DMA_K(2, 2); DMA_V(1, 1);
  qkt<DQ>(pA0, pA1, lds, kb, qr); MASK(pA0, pA1, 0); partialSM<DQ>(pA0, pA1, m_reg, mnA, alA);
  int kc = 1, kn = 3, vp = 0, vn = 2;
#define ADV() do { kc = (kc + 1) & 3; kn = (kn + 1) & 3; vp = (vp == 2 ? 0 : vp + 1); vn = (vn == 2 ? 0 : vn + 1); } while (0)
  for (int j = 1; j + 1 < NT; j += 2) {
    { const bool full = j + 2 < NT; if (full) { DMA_K(j + 2, kn); } DMA_V(j + 1, vn);
      SBAR(); qkt<DQ>(pB0, pB1, lds + kc * SLOTK, kb, qr); MASK(pB0, pB1, j);
      finishSM(pA0, pA1, alA, l_reg, pa0, pa1, pa2, pa3); SBAR();
      pv_d0(o, vb0 + vp * SLOTV, pa0, pa1, pa2, pa3); partialSM<DQ>(pB0, pB1, m_reg, mnB, alB);
      RESC(alB); WAIT_BARN(full); ADV(); }
    { const bool full = j + 3 < NT; if (full) { DMA_K(j + 3, kn); } DMA_V(j + 2, vn);
      SBAR(); qkt<DQ>(pA0, pA1, lds + kc * SLOTK, kb, qr); MASK(pA0, pA1, j + 1);
      finishSM(pB0, pB1, alB, l_reg, pa0, pa1, pa2, pa3); SBAR();
      pv_d0(o, vb0 + vp * SLOTV, pa0, pa1, pa2, pa3); partialSM<DQ>(pA0, pA1, m_reg, mnA, alA);
      RESC(alA); WAIT_BARN(full); ADV(); }
  }
  SBAR(); qkt<DQ>(pB0, pB1, lds + kc * SLOTK, kb, qr); MASK(pB0, pB1, NT - 1);
  finishSM(pA0, pA1, alA, l_reg, pa0, pa1, pa2, pa3); SBAR();
  pv_d0(o, vb0 + vp * SLOTV, pa0, pa1, pa2, pa3); partialSM<DQ>(pB0, pB1, m_reg, mnB, alB);
  RESC(alB);
  finishSM(pB0, pB1, alB, l_reg, pa0, pa1, pa2, pa3); SBAR();
  pv_d0(o, vb0 + (vp == 2 ? 0 : vp + 1) * SLOTV, pa0, pa1, pa2, pa3);
  if (hi == 0) li_l[r32] = l_reg; asm volatile("s_waitcnt lgkmcnt(0)" ::: "memory");
  float rli[16];
#pragma unroll
  for (int r = 0; r < 16; ++r) rli[r] = __builtin_amdgcn_rcpf(li_l[crow(r, hi)]);
  bf16_t* Ow = Ob + (long)(wid * QBLK) * ldo;
  { if (((NT - 1) & 3) != 3) WAIT_BAR();
    LAS bf16_t* stg = (LAS bf16_t*)(lds + wid * 8192);
#pragma unroll
    for (int r = 0; r < 16; ++r) { const int orow = crow(r, hi);
#pragma unroll
      for (int d0 = 0; d0 < 4; ++d0) stg[orow * 128 + d0 * 32 + r32] = f2bf(o[d0][r] * rli[r]); }
    asm volatile("s_waitcnt lgkmcnt(0)" ::: "memory");
#pragma unroll
    for (int i = 0; i < 8; ++i) { const int row = i * 4 + (lane >> 4), ch = lane & 15; const u32x4 v = *(const LAS u32x4*)(stg + row * 128 + ch * 8); *(u32x4*)(Ow + (long)row * ldo + ch * 8) = v; } }
  WAIT_BAR();
#undef DMA_K
#undef DMA_V
#undef WAIT_BARN
#undef ADV
#undef WAIT_BAR
#undef RESC
#undef MASK
#undef NEXT3
}
#undef SBAR
}
#define XB_TMO      128
#define XB_XCNT(j)  (256  + 64 * (j))
#define XB_XSUB(j)  (1280 + 64 * (j))
#define XB_XGEN(j)  (2304 + 64 * (j))
#define XB_TOP      3328
#define XB_TOPGEN   3392
#define XCD_BAR_WORDS 3456
#define XB_SPIN_CAP (1u << 18)
constexpr size_t OFF_BAR = 23 * MiB;
__device__ __forceinline__ unsigned xb_ld(unsigned* p)              { return __hip_atomic_load(p, __ATOMIC_RELAXED, __HIP_MEMORY_SCOPE_AGENT); }
__device__ __forceinline__ unsigned xb_add(unsigned* p, unsigned v) { return __hip_atomic_fetch_add(p, v, __ATOMIC_RELAXED, __HIP_MEMORY_SCOPE_AGENT); }
__device__ __forceinline__ unsigned xb_xcc_id() { return (unsigned)__builtin_amdgcn_s_getreg((3 << 11) | 20) & 0xFu; }
#define XB_SPIN(cond, bar) do { unsigned _sp = 0; while (cond) { __builtin_amdgcn_s_sleep(1); \
    if ((++_sp & 255u) == 0u) { if (xb_ld(&(bar)[XB_TMO])) break; if (_sp > XB_SPIN_CAP) { atomicAdd(&(bar)[XB_TMO], 1u); break; } } } } while (0)
struct XcdBarrier { unsigned* bar; unsigned x; volatile LAS unsigned* st; };
__device__ __forceinline__ XcdBarrier xcd_barrier_post(unsigned* bar, volatile LAS unsigned* st) {
    XcdBarrier b; b.bar = bar; b.x = xb_xcc_id(); b.st = st;
    if (threadIdx.x == 0) (void)xb_add(&bar[XB_XCNT(b.x)], 1u);
    return b;
}
__device__ __forceinline__ void xcd_barrier_complete(unsigned* bar, unsigned x, unsigned& nloc, unsigned& nx) {
    const unsigned G = gridDim.x * gridDim.y * gridDim.z;
    unsigned sum, cnt, mine, sp = 0u;
    for (;;) {
        sum = 0u; cnt = 0u; mine = 0u;
#pragma unroll
        for (unsigned j = 0; j < 16; ++j) { const unsigned c = xb_ld(&bar[XB_XCNT(j)]); sum += c; cnt += (c > 0u) ? 1u : 0u; mine = (j == x) ? c : mine; }
        if (sum == G) break;
        __builtin_amdgcn_s_sleep(1);
        if ((++sp & 255u) == 0u) { if (xb_ld(&bar[XB_TMO])) break; if (sp > XB_SPIN_CAP) { atomicAdd(&bar[XB_TMO], 1u); break; } }
    }
    nloc = mine > 0u ? mine : 1u; nx = cnt > 0u ? cnt : 1u;
}
__device__ __forceinline__ void xcd_barrier(const XcdBarrier& b) {
    asm volatile("s_waitcnt vmcnt(0)" ::: "memory");
    __syncthreads();
    if (threadIdx.x == 0) {
        unsigned* bar = b.bar;
        __builtin_amdgcn_s_waitcnt(0);
        unsigned nloc = b.st[0], nx = b.st[1];
        if (nloc == 0u) { xcd_barrier_complete(bar, b.x, nloc, nx); b.st[0] = nloc; b.st[1] = nx; }
        const unsigned old = xb_add(&bar[XB_XSUB(b.x)], 1u);
        const unsigned gen = old / nloc;
        if (old + 1u == (gen + 1u) * nloc) {
            __builtin_amdgcn_fence(__ATOMIC_RELEASE, "agent");
            asm volatile("s_waitcnt vmcnt(0)" ::: "memory");
            const unsigned og = xb_add(&bar[XB_TOP], 1u);
            const unsigned tg = og / nx;
            if (og + 1u == (tg + 1u) * nx) xb_add(&bar[XB_TOPGEN], 1u);
            else XB_SPIN(xb_ld(&bar[XB_TOPGEN]) == tg, bar);
            __builtin_amdgcn_fence(__ATOMIC_ACQUIRE, "agent");
            xb_add(&bar[XB_XGEN(b.x)], 1u);
            asm volatile("s_waitcnt vmcnt(0)" ::: "memory");
        } else {
            XB_SPIN(xb_ld(&bar[XB_XGEN(b.x)]) == gen, bar);
            __builtin_amdgcn_fence(__ATOMIC_ACQUIRE, "agent");
            asm volatile("s_waitcnt vmcnt(0)" ::: "memory");
        }
    }
    __syncthreads();
}
constexpr int LDS_BYTES = 151616;
constexpr int LDS_BTAB = 149504, LDS_BARST = 149504 + 2048;
constexpr int NPH = 38;
#define LDS_WAIT() asm volatile("s_waitcnt lgkmcnt(0)" ::: "memory")

__device__ __forceinline__ int drow_map(int kind, int n) {
    if (kind == 0) { if (n < 1024) return n; if (n < 1088) return 8192 + (n - 1024); return n - 64; }
    if (kind == 1) { const int h = n / 192, j = n % 192; if (j < 128) return h * 128 + j; if (j < 160) return 1024 + 256 * (h >> 2) + (h & 3) * 32 + (j - 128); return 1024 + 256 * (h >> 2) + 128 + (h & 3) * 32 + (j - 160); }
    if (kind == 2) { const int h = n / 256, j = n % 256; if (j < 128) return h * 128 + j; return 1024 + h * 128 + (j - 128); }
    return n;
}
struct TrItem { const float* src; const float* gain; bf16_t* dst; int N, K; };
__device__ __forceinline__ bool tr_decode(const Args& a, int it, TrItem& t) {
    constexpr int PER_LAYER = 29632;
    if (it >= DEPTH * PER_LAYER) return false;
    const int l = it / PER_LAYER; int r = it % PER_LAYER;
    unsigned char* wl = a.ws + OFF_W + (size_t)l * WL_STRIDE;
    const float* W; int K, N, kind = 3; bf16_t* WT; const float* gain = nullptr;
    if (r < 8256) { W = a.in[I_WIN] + (size_t)l * DM * INT; K = 2048; N = INT; WT = (bf16_t*)(wl + WL_IN); kind = 0; }
    else if ((r -= 8256) < 384) { W = a.in[I_WUQ] + (size_t)l * 512 * 1536; K = 512; N = 1536; WT = (bf16_t*)(wl + WL_UQ); kind = 1; gain = a.in[I_NQA] + (size_t)l * 512; }
    else if ((r -= 384) < 512) { W = a.in[I_WUKV] + (size_t)l * 512 * 2048; K = 512; N = 2048; WT = (bf16_t*)(wl + WL_UKV); kind = 2; gain = a.in[I_NKVA] + (size_t)l * 512; }
    else if ((r -= 512) < 1024) { W = a.in[I_WOA] + (size_t)l * 1024 * 2048; K = 1024; N = 2048; WT = (bf16_t*)(wl + WL_OA); }
    else if ((r -= 1024) < 1024) { W = a.in[I_WOB] + (size_t)l * 1024 * 2048; K = 1024; N = 2048; WT = (bf16_t*)(wl + WL_OB); }
    else if ((r -= 1024) < 2048) { W = a.in[I_WOUT] + (size_t)l * 2048 * 2048; K = 2048; N = 2048; WT = (bf16_t*)(wl + WL_OUT); }
    else if ((r -= 2048) < 8192) { W = a.in[I_WFF1] + (size_t)l * DM * DFF; K = 2048; N = DFF; WT = (bf16_t*)(wl + WL_FF1); }
    else { r -= 8192; W = a.in[I_WFF2] + (size_t)l * DFF * DM; K = DFF; N = 2048; WT = (bf16_t*)(wl + WL_FF2); }
    const int nblk = N / 32, kb = r / nblk, nb = r % nblk, k0 = kb * 64, n0 = nb * 32;
    t.src = W + (size_t)k0 * N + n0; t.gain = gain ? gain + k0 : nullptr; t.dst = WT + (size_t)drow_map(kind, n0) * K + k0; t.N = N; t.K = K; return true;
}
__device__ __forceinline__ void tr_load(const TrItem& t, f32x4 (&v)[8], float (&gv)[8], int lane) {
#pragma unroll
    for (int i = 0; i < 8; ++i) { const int kk = 8 * i + (lane >> 3); v[i] = *(const f32x4*)(t.src + (size_t)kk * t.N + (lane & 7) * 4); gv[i] = t.gain ? t.gain[kk] : 1.0f; }
}
__device__ __forceinline__ void tr_store(const TrItem& t, const f32x4 (&v)[8], const float (&gv)[8], LAS float* scr, int lane) {
#pragma unroll
    for (int i = 0; i < 8; ++i) { const int kk = 8 * i + (lane >> 3); const f32x4 x = v[i] * gv[i];
        LAS float* d = scr + kk * 33 + (lane & 7) * 4; d[0] = x[0]; d[1] = x[1]; d[2] = x[2]; d[3] = x[3]; }
    LDS_WAIT(); asm volatile("" ::: "memory");
    const int c = lane & 7;
#pragma unroll
    for (int j = 0; j < 4; ++j) { const int n = (lane >> 3) + 8 * j; const LAS float* s = scr + (8 * c) * 33 + n;
        u32x4 o; o.x = cvt_pk_bf16(s[0 * 33], s[1 * 33]); o.y = cvt_pk_bf16(s[2 * 33], s[3 * 33]); o.z = cvt_pk_bf16(s[4 * 33], s[5 * 33]); o.w = cvt_pk_bf16(s[6 * 33], s[7 * 33]);
        *(u32x4*)(t.dst + (size_t)n * t.K + 8 * c) = o; }
    LDS_WAIT(); asm volatile("" ::: "memory");
}
__device__ __forceinline__ void prologue(const Args& a, LAS unsigned char* lds) {
    int tid_ = threadIdx.x; asm volatile("" : "+v"(tid_));
    const int tid = tid_, lane = tid & 63, wave = tid >> 6, G = gridDim.x;
    float2* CS = (float2*)(a.ws + OFF_CS);
    for (int idx = blockIdx.x * 512 + tid; idx < S * 32; idx += G * 512) { const int pos = idx >> 5, i = idx & 31; float c, s; sincos_acc((float)pos * inv_freq(i), c, s); CS[idx] = make_float2(c, s); }
    LAS float* scr = (LAS float*)(lds + wave * 8448);
    const int gw = blockIdx.x * 8 + wave, NGW = G * 8;
    TrItem cur, nxt; f32x4 v[8], vn[8]; float gv[8], gn[8];
    bool have = tr_decode(a, gw, cur);
    if (have) tr_load(cur, v, gv, lane);
    for (int it = gw; have; it += NGW) {
        const bool hn = tr_decode(a, it + NGW, nxt);
        if (hn) tr_load(nxt, vn, gn, lane);
        tr_store(cur, v, gv, scr, lane);
        cur = nxt; have = hn;
#pragma unroll
        for (int i = 0; i < 8; ++i) { v[i] = vn[i]; gv[i] = gn[i]; }
    }
}
template <bool F32OUT>
__device__ __forceinline__ void norm_phase(const float* X, const float* g, bf16_t* Ub, float* Of) {
    int tid_ = threadIdx.x; asm volatile("" : "+v"(tid_));
    const int lane = tid_ & 63, gw = blockIdx.x * 8 + (tid_ >> 6), NGW = gridDim.x * 8;
    for (int row = gw; row < S; row += NGW) {
        const f32x4* xr = (const f32x4*)(X + (size_t)row * DM);
        f32x4 v[8]; float ss = 0.f;
#pragma unroll
        for (int j = 0; j < 8; ++j) { v[j] = xr[lane + 64 * j]; ss += (v[j][0] * v[j][0] + v[j][1] * v[j][1]) + (v[j][2] * v[j][2] + v[j][3] * v[j][3]); }
#pragma unroll
        for (int o = 1; o < 64; o <<= 1) ss += __shfl_xor(ss, o);
        const float rinv = rsqrtf(ss * (1.0f / DM) + EPS);
        const f32x4* gr = (const f32x4*)g;
#pragma unroll
        for (int j = 0; j < 8; ++j) { const f32x4 o = v[j] * rinv * gr[lane + 64 * j];
            if (F32OUT) ((f32x4*)(Of + (size_t)row * DM))[lane + 64 * j] = o;
            else ((uint2*)(Ub + (size_t)row * DM))[lane + 64 * j] = make_uint2(cvt_pk_bf16(o[0], o[1]), cvt_pk_bf16(o[2], o[3])); }
    }
}
__device__ __forceinline__ void norm_kpe_phase(const float* X, const float* g, bf16_t* Ub, const bf16_t* Wk, const float2* CS, bf16_t* KM, LAS unsigned char* lds) {
    constexpr int PITCH = 4096 + 16;
    int tid_ = threadIdx.x; asm volatile("" : "+v"(tid_));
    const int tid = tid_, lane = tid & 63, wid = tid >> 6, r32 = lane & 31, hi = lane >> 5;
    for (int rb = blockIdx.x; rb < S / 32; rb += gridDim.x) {
        const int base = rb * 32;
#pragma unroll 1
        for (int rr = 0; rr < 4; ++rr) { const int lr = 4 * wid + rr, row = base + lr;
            const f32x4* xr = (const f32x4*)(X + (size_t)row * DM); f32x4 v[8]; float ss = 0.f;
#pragma unroll
            for (int j = 0; j < 8; ++j) { v[j] = xr[lane + 64 * j]; ss += (v[j][0] * v[j][0] + v[j][1] * v[j][1]) + (v[j][2] * v[j][2] + v[j][3] * v[j][3]); }
#pragma unroll
            for (int o = 1; o < 64; o <<= 1) ss += __shfl_xor(ss, o);
            const float rinv = rsqrtf(ss * (1.0f / DM) + EPS); const f32x4* gr = (const f32x4*)g;
#pragma unroll
            for (int j = 0; j < 8; ++j) { const f32x4 o = v[j] * rinv * gr[lane + 64 * j]; typedef unsigned u32x2 __attribute__((ext_vector_type(2))); const u32x2 w = {cvt_pk_bf16(o[0], o[1]), cvt_pk_bf16(o[2], o[3])};
                ((u32x2*)(Ub + (size_t)row * DM))[lane + 64 * j] = w; *(LAS u32x2*)(lds + lr * PITCH + (lane + 64 * j) * 8) = w; } }
        __syncthreads();
        att::f32x16 a0 = {}, a1 = {};
#pragma unroll 4
        for (int ks = 0; ks < 16; ++ks) { const int k0 = 256 * wid + 16 * ks + hi * 8;
            const bf16x8 w0 = *(const bf16x8*)(Wk + (size_t)r32 * 2048 + k0), w1 = *(const bf16x8*)(Wk + (size_t)(32 + r32) * 2048 + k0);
            const bf16x8 uu = *(const LAS bf16x8*)(lds + r32 * PITCH + k0 * 2);
            a0 = __builtin_amdgcn_mfma_f32_32x32x16_bf16(w0, uu, a0, 0, 0, 0); a1 = __builtin_amdgcn_mfma_f32_32x32x16_bf16(w1, uu, a1, 0, 0, 0); }
        __syncthreads();
        LAS float* P = (LAS float*)lds;
#pragma unroll
        for (int r = 0; r < 16; ++r) { P[(wid * 32 + r) * 64 + lane] = a0[r]; P[(wid * 32 + 16 + r) * 64 + lane] = a1[r]; }
        __syncthreads();
#pragma unroll
        for (int rr = 0; rr < 2; ++rr) { const int r = 2 * wid + rr; float x1 = 0.f, x2 = 0.f;
#pragma unroll
            for (int w = 0; w < 8; ++w) { x1 += P[(w * 32 + r) * 64 + lane]; x2 += P[(w * 32 + 16 + r) * 64 + lane]; }
            const int row = base + r32, i = att::crow(r, hi); const float2 cs = CS[(size_t)row * 32 + i];
            const bf16_t o1 = f2bf(x1 * cs.x - x2 * cs.y), o2 = f2bf(x2 * cs.x + x1 * cs.y);
            bf16_t* kr = KM + (size_t)row * 1536 + 128 + i;
#pragma unroll
            for (int h = 0; h < 8; ++h) { kr[h * 192] = o1; kr[h * 192 + 32] = o2; } }
        __syncthreads();
    }
}
#ifndef ATT_V2
#define ATT_V2 1
#endif
#if ATT_V2
#define ATTNS att2
#define ATT_LDS(p) ((LAS unsigned char*)(p))
#else
#define ATTNS att
#define ATT_LDS(p) ((char*)(p))
#endif
__device__ __forceinline__ void attn_phase(const Args& a, int l, unsigned char* lds) {
    unsigned char* ws = a.ws; asm volatile("" : "+s"(ws));
    int tid_ = threadIdx.x; asm volatile("" : "+v"(tid_));
    const int c = blockIdx.x, G = gridDim.x, tid = tid_, wid = tid >> 6, r32 = tid & 31;
    const att::NaCtx nc0{nullptr, 0, 0, 0, 0};
#ifndef NO_MLA
    for (int uidx = c; uidx < 256; uidx += G) { const int h = uidx & 7, qb = uidx >> 3;
        ATTNS::attn_unit<192, false>((const bf16_t*)(ws + OFF_QM) + (size_t)qb * 256 * 1536 + h * 192, 1536, (const bf16_t*)(ws + OFF_KM) + h * 192, 1536,
                                   (const bf16_t*)(ws + OFF_VM) + h * 128, 1024, (bf16_t*)(ws + OFF_ATA) + (size_t)qb * 256 * 1024 + h * 128, 1024, S / 64, ATT_LDS(lds), nc0, 0); }
#endif
#ifndef NO_NA
    float* btab = (float*)(lds + LDS_BTAB);
    for (int uidx = c; uidx < 256; uidx += G) { const int h = uidx & 7, g4 = uidx >> 3, r0 = 4 * g4, kr0 = min(max(r0 - 4, 0), 116);
        __syncthreads();
        if (tid < 465) btab[tid] = a.in[I_RPB][((size_t)l * 8 + h) * 465 + tid] * 11.313708498984761f;
        __syncthreads();
        att::NaCtx nc; nc.btab = btab; nc.r = r0 + (wid >> 1); nc.qc = (wid & 1) * 32 + r32; nc.cstart = min(max(nc.qc - 8, 0), 48); nc.wstart = min(max(nc.r - 4, 0), 120);
        att::attn_unit<128, true>((const bf16_t*)(ws + OFF_QNA) + (size_t)r0 * 64 * 1024 + h * 128, 1024, (const bf16_t*)(ws + OFF_KNA) + (size_t)kr0 * 64 * 1024 + h * 128, 1024,
                                  (const bf16_t*)(ws + OFF_VNA) + (size_t)kr0 * 64 * 1024 + h * 128, 1024, (bf16_t*)(ws + OFF_ATB) + (size_t)r0 * 64 * 1024 + h * 128, 1024, 12, (char*)lds, nc, kr0); }
#endif
}
#ifndef ONLY
#define ONLY -1
#endif
#define PHS(k) (ONLY < 0 || ONLY == (k))
__global__ void __launch_bounds__(512) mega(Args a) {
    extern __shared__ __attribute__((aligned(16))) unsigned char lds[];
    cg::grid_group grid = cg::this_grid();
    LAS unsigned char* ldsl = (LAS unsigned char*)lds;
    const int G = gridDim.x, c = blockIdx.x;
    volatile LAS unsigned* bst = (volatile LAS unsigned*)(ldsl + LDS_BARST);
    if (threadIdx.x < 2) bst[threadIdx.x] = 0u;
    __syncthreads();
    XcdBarrier xbar; xbar.bar = (unsigned*)(a.ws + OFF_BAR); xbar.x = 0; xbar.st = bst;
    if (a.ph_hi - a.ph_lo > 1) xbar = xcd_barrier_post((unsigned*)(a.ws + OFF_BAR), bst);
#define GRID_BAR() xcd_barrier(xbar)
#ifdef REPEAT_PRO
    if (a.ph_lo == 0) { prologue(a, ldsl); grid.sync(); }
#endif
    if (PHS(100) && a.ph_lo == 0) { prologue(a, ldsl); if (a.ph_hi > 1) grid.sync(); }
    const int plo = a.ph_lo < 1 ? 1 : a.ph_lo, phi = a.ph_hi > NPH - 1 ? NPH - 1 : a.ph_hi;
    for (int ph = plo; ph < phi; ++ph) {
#ifdef REPEAT_K
        for (int rep = 0; rep < (((ph - 1) % 9 == REPEAT_K) ? 2 : 1); ++rep) {
            if (rep) GRID_BAR();
#else
        {
#endif
            unsigned char* ws = a.ws; asm volatile("" : "+s"(ws));
            const int l = (ph - 1) / 9, k = (ph - 1) % 9;
            const float* xin = (l == 0) ? a.in[I_X] : a.out;
            unsigned char* wl = ws + OFF_W + (size_t)l * WL_STRIDE;
            if (PHS(0) && k == 0) norm_kpe_phase(xin, a.in[I_NMIX] + (size_t)l * DM, (bf16_t*)(ws + OFF_U), (const bf16_t*)(wl + WL_IN) + (size_t)8192 * 2048, (const float2*)(ws + OFF_CS), (bf16_t*)(ws + OFF_KM), ldsl);
            else if (PHS(1) && k == 1) {
                pg8::Gemm g{(const bf16_t*)(ws + OFF_U), nullptr, (const bf16_t*)(wl + WL_IN), nullptr, 2048}; pg8::StaticOrder so; so.init(S, 8192, G, c);
                pg8::EpiInF E{(bf16_t*)(ws + OFF_CQ), (bf16_t*)(ws + OFF_CKV), (bf16_t*)(ws + OFF_QNA), (bf16_t*)(ws + OFF_KNA), (bf16_t*)(ws + OFF_VNA), (bf16_t*)(ws + OFF_KM),
                              (f16_t*)(ws + OFF_GA), (f16_t*)(ws + OFF_GB), (float*)(ws + OFF_SSQ), (float*)(ws + OFF_KPER), (const float2*)(ws + OFF_CS)};
                pg8::gemm_phase<pg8::EpiInF, pg8::StaticOrder>(ldsl, g, so, E);
            } else if (PHS(2) && k == 2) {
                pg8::Gemm g{(const bf16_t*)(ws + OFF_CQ), (const bf16_t*)(ws + OFF_CKV), (const bf16_t*)(wl + WL_UQ), (const bf16_t*)(wl + WL_UKV), 512}; pg8::SchedQKV sq; sq.init(G, c);
                pg8::EpiQKVF E{(bf16_t*)(ws + OFF_QM), (bf16_t*)(ws + OFF_KM), (bf16_t*)(ws + OFF_VM), (const float*)(ws + OFF_SSQ), (const float2*)(ws + OFF_CS)};
                pg8::gemm_phase<pg8::EpiQKVF, pg8::SchedQKV>(ldsl, g, sq, E);
            } else if (PHS(3) && k == 3) attn_phase(a, l, lds);
            else if (PHS(4) && k == 4) {
                pg8::Gemm g{(const bf16_t*)(ws + OFF_ATA), (const bf16_t*)(ws + OFF_ATB), (const bf16_t*)(wl + WL_OA), (const bf16_t*)(wl + WL_OB), 1024}; pg8::SchedO sq; sq.init(G, c);
                pg8::EpiOF E{(float*)(ws + OFF_T), (const f16_t*)(ws + OFF_GA), (const f16_t*)(ws + OFF_GB), (bf16_t*)(ws + OFF_MRG)};
                pg8::gemm_phase<pg8::EpiOF, pg8::SchedO>(ldsl, g, sq, E);
            } else if (PHS(5) && k == 5) {
                pg8::Gemm g{(const bf16_t*)(ws + OFF_MRG), nullptr, (const bf16_t*)(wl + WL_OUT), nullptr, 2048}; pg8::StaticOrder so; so.init(S, 2048, G, c);
                pg8::EpiResF E{xin, a.out};
                pg8::gemm_phase<pg8::EpiResF, pg8::StaticOrder>(ldsl, g, so, E);
            } else if (PHS(6) && k == 6) norm_phase<false>(a.out, a.in[I_NMLP] + (size_t)l * DM, (bf16_t*)(ws + OFF_U), nullptr);
            else if (PHS(7) && k == 7) {
                pg8::Gemm g{(const bf16_t*)(ws + OFF_U), nullptr, (const bf16_t*)(wl + WL_FF1), nullptr, 2048}; pg8::StaticOrder so; so.init(S, DFF, G, c);
                pg8::EpiFF1F E{(bf16_t*)(ws + OFF_H)};
                pg8::gemm_phase<pg8::EpiFF1F, pg8::StaticOrder>(ldsl, g, so, E);
            } else if (PHS(8)) {
                pg8::Gemm g{(const bf16_t*)(ws + OFF_H), nullptr, (const bf16_t*)(wl + WL_FF2), nullptr, DFF}; pg8::StaticOrder so; so.init(S, 2048, G, c);
                pg8::EpiResF E{a.out, a.out};
                pg8::gemm_phase<pg8::EpiResF, pg8::StaticOrder>(ldsl, g, so, E);
            }
        }
#ifdef EXTRA_SYNC
        GRID_BAR();
#endif
        if (ph + 1 < a.ph_hi) GRID_BAR();
    }
    if (PHS(101) && a.ph_hi == NPH) norm_phase<true>(a.out, a.in[I_NFIN], nullptr, a.out);
}
#ifndef MODE
#define MODE 1
#endif
#ifndef FASTMASK
#define FASTMASK 0x1ff
#endif
#ifndef FASTPRO
#define FASTPRO 1
#endif
extern "C" void kernel_launch(void* const* d_in, const int* in_sizes, int n_in, void* d_out, int out_size, void* d_ws, size_t ws_size, hipStream_t stream) {
    static int grid = 0;
    if (grid == 0) {
        if (n_in != 15 || out_size != S * DM || ws_size < WS_END) { fprintf(stderr, "kernel_launch: bad shapes n_in %d out %d ws %zu (need %zu)\n", n_in, out_size, ws_size, (size_t)WS_END); grid = -1; return; }
        if (hipFuncSetAttribute((const void*)mega, hipFuncAttributeMaxDynamicSharedMemorySize, LDS_BYTES) != hipSuccess) { fprintf(stderr, "kernel_launch: hipFuncSetAttribute failed\n"); grid = -1; return; }
        int dev = 0, cus = 0, per_cu = 0;
        hipGetDevice(&dev); hipDeviceGetAttribute(&cus, hipDeviceAttributeMultiprocessorCount, dev);
        hipOccupancyMaxActiveBlocksPerMultiprocessor(&per_cu, (const void*)mega, 512, LDS_BYTES);
        if (per_cu < 1) { fprintf(stderr, "kernel_launch: occupancy query says %d blocks/CU\n", per_cu); per_cu = 1; }
        (void)hipGetLastError();
        grid = cus;
        fprintf(stderr, "kernel_launch: cus %d per_cu %d grid %d\n", cus, per_cu, grid);
    }
    if (grid < 0) return;
    Args a{}; fill_args(a, d_in, d_out, d_ws);
    if (hipMemsetAsync((char*)d_ws + OFF_BAR, 0, 16384, stream) != hipSuccess) { fprintf(stderr, "kernel_launch: memset failed\n"); return; }
#if MODE == 1
    a.ph_lo = 0; a.ph_hi = NPH;
    void* args[] = {&a};
    hipError_t e = hipLaunchCooperativeKernel((const void*)mega, dim3(grid), dim3(512), args, LDS_BYTES, stream);
    if (e != hipSuccess) fprintf(stderr, "cooperative launch failed: %s (grid %d)\n", hipGetErrorString(e), grid);
#else
    const Bufs b = get_bufs(a.ws);
    naive_prologue(a, b, stream);
    if (FASTPRO) { a.ph_lo = 0; a.ph_hi = 1; hipLaunchKernelGGL(mega, dim3(grid), dim3(512), LDS_BYTES, stream, a); }
    for (int l = 0; l < DEPTH; ++l) for (int k = 0; k < 9; ++k) {
        if ((FASTMASK >> k) & 1) { a.ph_lo = 1 + 9 * l + k; a.ph_hi = a.ph_lo + 1; hipLaunchKernelGGL(mega, dim3(grid), dim3(512), LDS_BYTES, stream, a); }
        else naive_stage(l, k, a, b, stream);
    }
    naive_final(a, stream);
#endif
}
```

```cpp
#include <hip/hip_runtime.h>
#include <hip/hip_cooperative_groups.h>
#include <cstdio>
#include <cstdint>
#include <cmath>
namespace cg = cooperative_groups;

constexpr int S = 8192, DM = 2048, DEPTH = 4, NH = 8, DQK = 192, DFF = 8192, INT = 8256;
constexpr float EPS = 1e-6f;
typedef unsigned short bf16_t;
typedef _Float16 f16_t;

constexpr size_t MiB = 1u << 20;
constexpr size_t OFF_CS = 0;
constexpr size_t OFF_SSQ = 2 * MiB;
constexpr size_t OFF_KPER = 3 * MiB;
constexpr size_t OFF_QPER = 5 * MiB;
constexpr size_t OFF_U = 24 * MiB;
constexpr size_t OFF_CQ = 56 * MiB;
constexpr size_t OFF_CKV = 64 * MiB;
constexpr size_t OFF_QNA = 72 * MiB, OFF_KNA = 88 * MiB, OFF_VNA = 104 * MiB;
constexpr size_t OFF_GA = 120 * MiB, OFF_GB = 152 * MiB;
constexpr size_t OFF_QM = 184 * MiB, OFF_KM = 208 * MiB;
constexpr size_t OFF_VM = 232 * MiB;
constexpr size_t OFF_ATA = 248 * MiB, OFF_ATB = 264 * MiB;
constexpr size_t OFF_T = 280 * MiB;
constexpr size_t OFF_MRG = 344 * MiB;
constexpr size_t OFF_H = 376 * MiB;
constexpr size_t OFF_W = 504 * MiB;
constexpr size_t WL_IN = 0, WL_UQ = 33 * MiB, WL_UKV = WL_UQ + 3 * MiB / 2, WL_OA = WL_UKV + 2 * MiB, WL_OB = WL_OA + 4 * MiB,
                 WL_OUT = WL_OB + 4 * MiB, WL_FF1 = WL_OUT + 8 * MiB, WL_FF2 = WL_FF1 + 32 * MiB, WL_STRIDE = 117 * MiB;
constexpr size_t WS_END = OFF_W + 4 * WL_STRIDE;
constexpr int NIN_PAD = 8448;

__device__ __forceinline__ float bf2f(bf16_t v) { return __uint_as_float((unsigned)v << 16); }
__device__ __forceinline__ bf16_t f2bf(float f) { unsigned u = __float_as_uint(f); return (bf16_t)((u + 0x7fffu + ((u >> 16) & 1u)) >> 16); }
__device__ __forceinline__ unsigned pk2(float lo, float hi) { return (unsigned)f2bf(lo) | ((unsigned)f2bf(hi) << 16); }
__device__ __forceinline__ float sigmoidf(float v) { return __builtin_amdgcn_rcpf(1.0f + __expf(-v)); }

struct Args {
    const float* in[15];
    float* out;
    unsigned char* ws;
    int ph_lo, ph_hi;
};
__device__ __forceinline__ float inv_freq(int i) { double p = 1.0; for (int k = 0; k < i; ++k) p *= 0.7498942093324559; return (float)p; }
enum { I_X = 0, I_NMIX, I_WIN, I_NQA, I_WUQ, I_NKVA, I_WUKV, I_RPB, I_WOA, I_WOB, I_WOUT, I_NMLP, I_WFF1, I_WFF2, I_NFIN };

__device__ __forceinline__ void sincos_acc(float a, float& c, float& s) {
    const double x = (double)a;
    const double k = rint(x * 0.15915494309189535);
    double r = fma(-k, 6.283185307179586, x); r = fma(-k, 2.4492935982947064e-16, r);
    const double q = rint(r * 0.6366197723675814);
    double t = fma(-q, 1.5707963267948966, r); t = fma(-q, 6.123233995736766e-17, t);
    const int qi = ((int)q) & 3;
    const double t2 = t * t;
    const double sp = t * (1.0 + t2 * (-1.0 / 6 + t2 * (1.0 / 120 + t2 * (-1.0 / 5040 + t2 * (1.0 / 362880 + t2 * (-1.0 / 39916800 + t2 * (1.0 / 6227020800.0)))))));
    const double cp = 1.0 + t2 * (-0.5 + t2 * (1.0 / 24 + t2 * (-1.0 / 720 + t2 * (1.0 / 40320 + t2 * (-1.0 / 3628800 + t2 * (1.0 / 479001600 + t2 * (-1.0 / 87178291200.0)))))));
    double ss, cc;
    if (qi == 0) { ss = sp; cc = cp; } else if (qi == 1) { ss = cp; cc = -sp; } else if (qi == 2) { ss = -sp; cc = -cp; } else { ss = -cp; cc = sp; }
    c = (float)cc; s = (float)ss;
}
namespace nv {
__global__ __launch_bounds__(256) void k_cs(float2* CS, Args a) {
    const int idx = blockIdx.x * 256 + threadIdx.x;
    if (idx >= S * 32) return;
    const int pos = idx >> 5, i = idx & 31;
    const float ang = (float)pos * inv_freq(i);
    float c, s; sincos_acc(ang, c, s);
    CS[idx] = make_float2(c, s);
}
template <bool F32OUT>
__global__ __launch_bounds__(256) void k_norm(const float* X, const float* g, bf16_t* Ub, float* Of) {
    const int row = (blockIdx.x * 256 + threadIdx.x) >> 6, lane = threadIdx.x & 63;
    if (row >= S) return;
    const float4* xr = (const float4*)(X + (size_t)row * DM);
    float4 v[8]; float ss = 0.f;
#pragma unroll
    for (int j = 0; j < 8; ++j) { v[j] = xr[lane + 64 * j]; ss += v[j].x * v[j].x + v[j].y * v[j].y + v[j].z * v[j].z + v[j].w * v[j].w; }
#pragma unroll
    for (int o = 1; o < 64; o <<= 1) ss += __shfl_xor(ss, o);
    const float rinv = rsqrtf(ss * (1.0f / DM) + EPS);
    const float4* gr = (const float4*)g;
#pragma unroll
    for (int j = 0; j < 8; ++j) {
        const float4 gg = gr[lane + 64 * j];
        const float o0 = v[j].x * rinv * gg.x, o1 = v[j].y * rinv * gg.y, o2 = v[j].z * rinv * gg.z, o3 = v[j].w * rinv * gg.w;
        if (F32OUT) ((float4*)(Of + (size_t)row * DM))[lane + 64 * j] = make_float4(o0, o1, o2, o3);
        else ((uint2*)(Ub + (size_t)row * DM))[lane + 64 * j] = make_uint2(pk2(o0, o1), pk2(o2, o3));
    }
}
__global__ __launch_bounds__(256) void k_ssq(const bf16_t* CQ, const bf16_t* CKV, float* SSQ) {
    const int row = (blockIdx.x * 256 + threadIdx.x) >> 6, lane = threadIdx.x & 63;
    if (row >= S) return;
    float a = 0.f, b = 0.f;
    for (int j = lane; j < 512; j += 64) { const float x = bf2f(CQ[(size_t)row * 512 + j]), y = bf2f(CKV[(size_t)row * 512 + j]); a += x * x; b += y * y; }
#pragma unroll
    for (int o = 1; o < 64; o <<= 1) { a += __shfl_xor(a, o); b += __shfl_xor(b, o); }
    if (lane < 16) SSQ[(size_t)row * 16 + lane] = (lane == 0) ? a : (lane == 8 ? b : 0.f);
}
__device__ __forceinline__ float rinv_from_ssq(const float* SSQ, int row, int off) {
    const float4 a = *(const float4*)(SSQ + (size_t)row * 16 + off), b = *(const float4*)(SSQ + (size_t)row * 16 + off + 4);
    const float s = ((a.x + a.y) + (a.z + a.w)) + ((b.x + b.y) + (b.z + b.w));
    return rsqrtf(s * (1.0f / 512.0f) + EPS);
}
struct EpiIn { bf16_t *CQ, *CKV, *QNA, *KNA, *VNA; f16_t *GA, *GB; float* KPER;
    __device__ __forceinline__ void operator()(int row, int col, float v) const {
        if (col < 512) CQ[(size_t)row * 512 + col] = f2bf(v);
        else if (col < 1024) CKV[(size_t)row * 512 + col - 512] = f2bf(v);
        else if (col < 1088) KPER[(size_t)row * 64 + col - 1024] = v;
        else if (col < 2112) QNA[(size_t)row * 1024 + col - 1088] = f2bf(v);
        else if (col < 3136) KNA[(size_t)row * 1024 + col - 2112] = f2bf(v);
        else if (col < 4160) VNA[(size_t)row * 1024 + col - 3136] = f2bf(v);
        else if (col < 6208) GA[(size_t)row * 2048 + col - 4160] = (f16_t)sigmoidf(v);
        else GB[(size_t)row * 2048 + col - 6208] = (f16_t)sigmoidf(v);
    } };
struct EpiQ { bf16_t* QM; float* QPER; const float* SSQ;
    __device__ __forceinline__ void operator()(int row, int col, float v) const {
        v *= rinv_from_ssq(SSQ, row, 0); const int h = col / 192, j = col % 192;
        if (j < 128) QM[(size_t)row * 1536 + col] = f2bf(v); else QPER[(size_t)row * 512 + h * 64 + j - 128] = v;
    } };
struct EpiKV { bf16_t *KM, *VM; const float* SSQ;
    __device__ __forceinline__ void operator()(int row, int col, float v) const {
        v *= rinv_from_ssq(SSQ, row, 8); const int h = col / 256, j = col % 256;
        if (j < 128) KM[(size_t)row * 1536 + h * 192 + j] = f2bf(v); else VM[(size_t)row * 1024 + h * 128 + j - 128] = f2bf(v);
    } };
struct EpiOA { float* T; const f16_t* GA;
    __device__ __forceinline__ void operator()(int row, int col, float v) const { const size_t i = (size_t)row * 2048 + col; T[i] = (float)GA[i] * v; } };
struct EpiOB { const float* T; const f16_t* GB; bf16_t* MRG;
    __device__ __forceinline__ void operator()(int row, int col, float v) const { const size_t i = (size_t)row * 2048 + col; MRG[i] = f2bf(T[i] + (float)GB[i] * v); } };
struct EpiRes { const float* XI; float* XO;
    __device__ __forceinline__ void operator()(int row, int col, float v) const { const size_t i = (size_t)row * 2048 + col; XO[i] = XI[i] + v; } };
struct EpiFF1 { bf16_t* H;
    __device__ __forceinline__ void operator()(int row, int col, float v) const { const float r = v > 0.f ? v : 0.f; H[(size_t)row * DFF + col] = f2bf(r * r); } };

template <class Epi>
__global__ __launch_bounds__(256) void k_gemm(const bf16_t* A, int lda, const float* W, int ldw, const float* gain, int N, int K, Epi E) {
    __shared__ float As[16][132]; __shared__ float Bs[16][132];
    const int t = threadIdx.x, bm = blockIdx.y * 128, bn = blockIdx.x * 128, ty = t >> 4, tx = t & 15;
    float acc[8][8];
#pragma unroll
    for (int i = 0; i < 8; ++i)
#pragma unroll
        for (int j = 0; j < 8; ++j) acc[i][j] = 0.f;
    for (int k0 = 0; k0 < K; k0 += 16) {
        { const int r = t >> 1, kk = (t & 1) * 8; const uint4 v = *(const uint4*)(A + (size_t)(bm + r) * lda + k0 + kk);
          const unsigned w[4] = {v.x, v.y, v.z, v.w};
#pragma unroll
          for (int i = 0; i < 4; ++i) { float lo = __uint_as_float(w[i] << 16), hi = __uint_as_float(w[i] & 0xffff0000u);
              if (gain) { lo *= gain[k0 + kk + 2 * i]; hi *= gain[k0 + kk + 2 * i + 1]; }
              As[kk + 2 * i][r] = lo; As[kk + 2 * i + 1][r] = hi; } }
#pragma unroll
        for (int i = 0; i < 2; ++i) { const int k = (t >> 5) + 8 * i, n = (t & 31) * 4;
            float4 v = make_float4(0.f, 0.f, 0.f, 0.f); if (bn + n < N) v = *(const float4*)(W + (size_t)(k0 + k) * ldw + bn + n);
            *(float4*)&Bs[k][n] = v; }
        __syncthreads();
#pragma unroll
        for (int kk = 0; kk < 16; ++kk) {
            float a[8], b[8];
            const float4 a0 = *(const float4*)&As[kk][ty * 8], a1 = *(const float4*)&As[kk][ty * 8 + 4];
            const float4 b0 = *(const float4*)&Bs[kk][tx * 8], b1 = *(const float4*)&Bs[kk][tx * 8 + 4];
            a[0] = a0.x; a[1] = a0.y; a[2] = a0.z; a[3] = a0.w; a[4] = a1.x; a[5] = a1.y; a[6] = a1.z; a[7] = a1.w;
            b[0] = b0.x; b[1] = b0.y; b[2] = b0.z; b[3] = b0.w; b[4] = b1.x; b[5] = b1.y; b[6] = b1.z; b[7] = b1.w;
#pragma unroll
            for (int i = 0; i < 8; ++i)
#pragma unroll
                for (int j = 0; j < 8; ++j) acc[i][j] = fmaf(a[i], b[j], acc[i][j]);
        }
        __syncthreads();
    }
#pragma unroll
    for (int i = 0; i < 8; ++i)
#pragma unroll
        for (int j = 0; j < 8; ++j) { const int row = bm + ty * 8 + i, col = bn + tx * 8 + j; if (col < N) E(row, col, acc[i][j]); }
}
template <bool DOK, bool DOQ>
__global__ __launch_bounds__(256) void k_rope(const float2* CS, const float* KPER, const float* QPER, bf16_t* KM, bf16_t* QM) {
    const int idx = blockIdx.x * 256 + threadIdx.x; if (idx >= S * 32) return;
    const int row = idx >> 5, i = idx & 31; const float2 cs = CS[idx];
    if (DOK) { const float x1 = KPER[(size_t)row * 64 + i], x2 = KPER[(size_t)row * 64 + 32 + i];
      const bf16_t o1 = f2bf(x1 * cs.x - x2 * cs.y), o2 = f2bf(x2 * cs.x + x1 * cs.y);
      for (int h = 0; h < 8; ++h) { KM[(size_t)row * 1536 + h * 192 + 128 + i] = o1; KM[(size_t)row * 1536 + h * 192 + 160 + i] = o2; } }
    if (DOQ) for (int h = 0; h < 8; ++h) { const float x1 = QPER[(size_t)row * 512 + h * 64 + i], x2 = QPER[(size_t)row * 512 + h * 64 + 32 + i];
        QM[(size_t)row * 1536 + h * 192 + 128 + i] = f2bf(x1 * cs.x - x2 * cs.y); QM[(size_t)row * 1536 + h * 192 + 160 + i] = f2bf(x2 * cs.x + x1 * cs.y); }
}
template <bool NA>
__global__ __launch_bounds__(256) void k_attn(const bf16_t* Q, const bf16_t* Kb, const bf16_t* Vb, bf16_t* O, const float* rpb) {
    constexpr int DQ = NA ? 128 : 192, PER = DQ / 64, LDQ = NA ? 1024 : 1536;
    const int wave = (blockIdx.x * 256 + threadIdx.x) >> 6, lane = threadIdx.x & 63;
    const int q = wave >> 3, h = wave & 7;
    const float scale = NA ? 0.08838834764831845f : 0.07216878364870323f;
    float qv[PER];
#pragma unroll
    for (int i = 0; i < PER; ++i) qv[i] = bf2f(Q[(size_t)q * LDQ + h * DQ + lane * PER + i]);
    float m = -1e30f, l = 0.f, o0 = 0.f, o1 = 0.f;
    const int r = q >> 6, c = q & 63;
    const int rs = min(max(r - 4, 0), 120), cs = min(max(c - 8, 0), 48);
    const int nkeys = NA ? 128 : S;
    for (int kk = 0; kk < nkeys; ++kk) {
        int key = kk; float bias = 0.f;
        if (NA) { const int i = kk >> 4, kc = cs + (kk & 15), kr = rs + i; key = kr * 64 + kc;
            const int dy = kr - r + 7, dx = min(max(kc - c, -15), 15) + 15; bias = rpb[h * 465 + dy * 31 + dx]; }
        float s = 0.f;
#pragma unroll
        for (int i = 0; i < PER; ++i) s += qv[i] * bf2f(Kb[(size_t)key * LDQ + h * DQ + lane * PER + i]);
#pragma unroll
        for (int o = 1; o < 64; o <<= 1) s += __shfl_xor(s, o);
        s = s * scale + bias;
        const float mn = fmaxf(m, s), al = __expf(m - mn), p = __expf(s - mn);
        const unsigned vv = *(const unsigned*)(Vb + (size_t)key * 1024 + h * 128 + lane * 2);
        l = l * al + p; o0 = o0 * al + p * __uint_as_float(vv << 16); o1 = o1 * al + p * __uint_as_float(vv & 0xffff0000u); m = mn;
    }
    const float il = 1.0f / l;
    *(unsigned*)(O + (size_t)q * 1024 + h * 128 + lane * 2) = pk2(o0 * il, o1 * il);
}
}
static void fill_args(Args& a, void* const* d_in, void* d_out, void* d_ws) {
    for (int i = 0; i < 15; ++i) a.in[i] = (const float*)d_in[i];
    a.out = (float*)d_out; a.ws = (unsigned char*)d_ws;
    a.ph_lo = 0; a.ph_hi = 0;
}
struct Bufs { float2* CS; float *SSQ, *KPER, *QPER, *T; bf16_t *U, *CQ, *CKV, *QNA, *KNA, *VNA, *QM, *KM, *VM, *ATA, *ATB, *MRG, *H; f16_t *GA, *GB; };
static Bufs get_bufs(unsigned char* ws) {
    Bufs b; b.CS = (float2*)(ws + OFF_CS); b.SSQ = (float*)(ws + OFF_SSQ); b.KPER = (float*)(ws + OFF_KPER); b.QPER = (float*)(ws + OFF_QPER); b.T = (float*)(ws + OFF_T);
    b.U = (bf16_t*)(ws + OFF_U); b.CQ = (bf16_t*)(ws + OFF_CQ); b.CKV = (bf16_t*)(ws + OFF_CKV); b.QNA = (bf16_t*)(ws + OFF_QNA); b.KNA = (bf16_t*)(ws + OFF_KNA); b.VNA = (bf16_t*)(ws + OFF_VNA);
    b.QM = (bf16_t*)(ws + OFF_QM); b.KM = (bf16_t*)(ws + OFF_KM); b.VM = (bf16_t*)(ws + OFF_VM); b.ATA = (bf16_t*)(ws + OFF_ATA); b.ATB = (bf16_t*)(ws + OFF_ATB);
    b.MRG = (bf16_t*)(ws + OFF_MRG); b.H = (bf16_t*)(ws + OFF_H); b.GA = (f16_t*)(ws + OFF_GA); b.GB = (f16_t*)(ws + OFF_GB); return b;
}
static void naive_stage(int l, int k, const Args& a, const Bufs& b, hipStream_t st) {
    const float* x = a.in[I_X]; float* out = a.out; const float* xin = (l == 0) ? x : out;
    const float* w_in = a.in[I_WIN] + (size_t)l * DM * INT; const float* w_uq = a.in[I_WUQ] + (size_t)l * 512 * 1536; const float* w_ukv = a.in[I_WUKV] + (size_t)l * 512 * 2048;
    const float* w_oa = a.in[I_WOA] + (size_t)l * 1024 * 2048; const float* w_ob = a.in[I_WOB] + (size_t)l * 1024 * 2048; const float* w_out = a.in[I_WOUT] + (size_t)l * 2048 * 2048;
    const float* w_ff1 = a.in[I_WFF1] + (size_t)l * DM * DFF; const float* w_ff2 = a.in[I_WFF2] + (size_t)l * DFF * DM;
    const dim3 blk(256); const int rowgrid = S * 64 / 256;
    switch (k) {
    case 0: nv::k_norm<false><<<rowgrid, blk, 0, st>>>(xin, a.in[I_NMIX] + (size_t)l * DM, b.U, nullptr); break;
    case 1: { nv::EpiIn e{b.CQ, b.CKV, b.QNA, b.KNA, b.VNA, b.GA, b.GB, b.KPER};
        nv::k_gemm<nv::EpiIn><<<dim3(65, 64), blk, 0, st>>>(b.U, 2048, w_in, INT, nullptr, INT, 2048, e);
        nv::k_ssq<<<rowgrid, blk, 0, st>>>(b.CQ, b.CKV, b.SSQ);
        nv::k_rope<true, false><<<S * 32 / 256, blk, 0, st>>>(b.CS, b.KPER, b.QPER, b.KM, b.QM); break; }
    case 2: { nv::EpiQ eq{b.QM, b.QPER, b.SSQ}; nv::k_gemm<nv::EpiQ><<<dim3(12, 64), blk, 0, st>>>(b.CQ, 512, w_uq, 1536, a.in[I_NQA] + (size_t)l * 512, 1536, 512, eq);
        nv::EpiKV ek{b.KM, b.VM, b.SSQ}; nv::k_gemm<nv::EpiKV><<<dim3(16, 64), blk, 0, st>>>(b.CKV, 512, w_ukv, 2048, a.in[I_NKVA] + (size_t)l * 512, 2048, 512, ek);
        nv::k_rope<false, true><<<S * 32 / 256, blk, 0, st>>>(b.CS, b.KPER, b.QPER, b.KM, b.QM); break; }
    case 3: nv::k_attn<false><<<S * 8 * 64 / 256, blk, 0, st>>>(b.QM, b.KM, b.VM, b.ATA, nullptr);
        nv::k_attn<true><<<S * 8 * 64 / 256, blk, 0, st>>>(b.QNA, b.KNA, b.VNA, b.ATB, a.in[I_RPB] + (size_t)l * 8 * 465); break;
    case 4: { nv::EpiOA ea{b.T, b.GA}; nv::k_gemm<nv::EpiOA><<<dim3(16, 64), blk, 0, st>>>(b.ATA, 1024, w_oa, 2048, nullptr, 2048, 1024, ea);
        nv::EpiOB eb{b.T, b.GB, b.MRG}; nv::k_gemm<nv::EpiOB><<<dim3(16, 64), blk, 0, st>>>(b.ATB, 1024, w_ob, 2048, nullptr, 2048, 1024, eb); break; }
    case 5: { nv::EpiRes e{xin, out}; nv::k_gemm<nv::EpiRes><<<dim3(16, 64), blk, 0, st>>>(b.MRG, 2048, w_out, 2048, nullptr, 2048, 2048, e); break; }
    case 6: nv::k_norm<false><<<rowgrid, blk, 0, st>>>(out, a.in[I_NMLP] + (size_t)l * DM, b.U, nullptr); break;
    case 7: { nv::EpiFF1 e{b.H}; nv::k_gemm<nv::EpiFF1><<<dim3(64, 64), blk, 0, st>>>(b.U, 2048, w_ff1, DFF, nullptr, DFF, 2048, e); break; }
    case 8: { nv::EpiRes e{out, out}; nv::k_gemm<nv::EpiRes><<<dim3(16, 64), blk, 0, st>>>(b.H, DFF, w_ff2, 2048, nullptr, 2048, DFF, e); break; }
    }
}
static void naive_prologue(const Args& a, const Bufs& b, hipStream_t st) { nv::k_cs<<<S * 32 / 256, 256, 0, st>>>(b.CS, a); }
static void naive_final(const Args& a, hipStream_t st) { nv::k_norm<true><<<S * 64 / 256, 256, 0, st>>>(a.out, a.in[I_NFIN], nullptr, a.out); }
#define LAS __attribute__((address_space(3)))
typedef short bf16x8 __attribute__((ext_vector_type(8)));
typedef float f32x4 __attribute__((ext_vector_type(4)));
typedef unsigned u32x4 __attribute__((ext_vector_type(4)));
typedef _Float16 f16x2 __attribute__((ext_vector_type(2)));
__device__ __forceinline__ unsigned cvt_pk_bf16(float lo, float hi) { unsigned r; asm volatile("v_cvt_pk_bf16_f32 %0, %1, %2" : "=v"(r) : "v"(lo), "v"(hi)); return r; }
__device__ __forceinline__ unsigned cvt_pk_f16(float lo, float hi) { f16x2 h = {(_Float16)lo, (_Float16)hi}; return __builtin_bit_cast(unsigned, h); }
__device__ __forceinline__ float2 unpk_f16(unsigned w) { f16x2 h = __builtin_bit_cast(f16x2, w); return make_float2((float)h.x, (float)h.y); }
namespace pg8 {
constexpr int BM = 256, BK = 64, HALF = 128, HTB = HALF * BK * 2, STAGE_BYTES = 8 * HTB, NXCD = 8, WGM = 4;
__host__ __device__ __forceinline__ int lds_byte(int r, int c) { const int st = (r >> 4) * 2 + (c >> 5), rr = r & 15, cc = c & 31, ob = rr * 64 + cc * 2; return st * 1024 + (ob ^ (((ob >> 9) & 1) << 5)); }
__host__ __device__ __forceinline__ void stage_rc(int b, int& R, int& C) { const int st = b / 1024, sb = b % 1024, swz = sb ^ (((sb >> 9) & 1) << 5); R = (st >> 1) * 16 + swz / 64; C = (st & 1) * 32 + (swz % 64) / 2; }
__host__ __device__ __forceinline__ int perm32(int rho) { const int n = rho >> 4, i = rho & 15; return 8 * (i >> 2) + 4 * n + (i & 3); }
struct Unit { int pm, pn, z; };
struct Gemm { const bf16_t* A0; const bf16_t* A1; const bf16_t* B0; const bf16_t* B1; int K; };
struct StaticOrder {
    int nM, nN, nwg, G, c;
    __device__ void init(int M, int N, int G_, int c_) { nM = M / BM; nN = N / BM; nwg = nM * nN; G = G_; c = c_; }
    __device__ bool next(int i, Unit& u) const {
        const long L = (long)i * G + c; if (L >= nwg) return false;
        int wgid = (int)L; { const int q = nwg / NXCD, r = nwg % NXCD, xcd = wgid % NXCD, off = wgid / NXCD; wgid = (xcd < r ? xcd * (q + 1) : r * (q + 1) + (xcd - r) * q) + off; }
        const int nig = WGM * nN, gid = wgid / nig, fm = gid * WGM, gsz = (nM - fm) < WGM ? (nM - fm) : WGM;
        u.pm = fm + ((wgid % nig) % gsz); u.pn = (wgid % nig) / gsz; u.z = 0; return true;
    }
};
struct SchedQKV { StaticOrder so;
    __device__ void init(int G, int c) { so.init(S, 14 * 256, G, c); }
    __device__ bool next(int i, Unit& u) const { if (!so.next(i, u)) return false; if (u.pn >= 6) { u.pn -= 6; u.z = 1; } return true; } };
struct SchedO { StaticOrder so;
    __device__ void init(int G, int c) { so.init(S, 2048, G, c); }
    __device__ bool next(int i, Unit& u) const { if (!so.next(i >> 1, u)) return false; u.z = i & 1; return true; } };

template <class Epi, class Sched, bool ALIGN_EPI = true, bool SP2 = true>
__device__ __forceinline__ void gemm_phase(LAS unsigned char* lds, const Gemm g, const Sched& Sc, const Epi& E) {
    int tid_ = threadIdx.x; asm volatile("" : "+v"(tid_));
    const int tid = tid_, wid = __builtin_amdgcn_readfirstlane(tid >> 6), lane = tid & 63, wr = wid >> 2, wc = wid & 3, fr = lane & 15, fq = lane >> 4;
    const int K = g.K, nt = K / BK;
    unsigned voffA[2], voffB[2];
#pragma unroll
    for (int i = 0; i < 2; ++i) { int R, C; stage_rc(tid * 16 + i * 8192, R, C); const int Rb = Epi::PERM ? ((R & ~31) + perm32(R & 31)) : R;
        voffA[i] = (unsigned)(R * K + C) * 2u; voffB[i] = (unsigned)(Rb * K + C) * 2u; }
    const size_t kstep = (size_t)(BK * 2);
    const size_t hstep = (size_t)HALF * K * 2;
    const size_t tstep = 2 * hstep;
    const unsigned ldsw = (unsigned)wid * 1024u;
    const int aoff = lds_byte(wr * 64 + fr, fq * 8), boff = lds_byte(wc * 32 + fr, fq * 8);
#define PG8_SA(b, h) (((b) * 2 + (h)) * HTB)
#define PG8_SB(b, h) ((4 + (b) * 2 + (h)) * HTB)
#define PG8_STAGE(bufoff, gbase, voff) do { _Pragma("unroll") for (int _i = 0; _i < 2; ++_i) \
        __builtin_amdgcn_global_load_lds((const unsigned*)((const char*)(gbase) + (voff)[_i]), (LAS unsigned*)(lds + (bufoff) + ldsw + _i * 8192), 16, 0, 0); } while (0)
#define PG8_LDA(dst, b, h) do { _Pragma("unroll") for (int m = 0; m < 4; ++m) _Pragma("unroll") for (int k = 0; k < 2; ++k) dst[m][k] = *(const LAS bf16x8*)(lds + PG8_SA(b, h) + aoff + m * 2048 + k * 1024); } while (0)
#define PG8_LDB(dst, b, h) do { _Pragma("unroll") for (int n = 0; n < 2; ++n) _Pragma("unroll") for (int k = 0; k < 2; ++k) dst[n][k] = *(const LAS bf16x8*)(lds + PG8_SB(b, h) + boff + n * 2048 + k * 1024); } while (0)
#define PG8_MMA(ai, bj, At, Bt) do { __builtin_amdgcn_s_setprio(1); _Pragma("unroll") for (int m = 0; m < 4; ++m) _Pragma("unroll") for (int n = 0; n < 2; ++n) _Pragma("unroll") for (int k = 0; k < 2; ++k) \
        acc[ai][bj][m][n] = __builtin_amdgcn_mfma_f32_16x16x32_bf16(Bt[n][k], At[m][k], acc[ai][bj][m][n], 0, 0, 0); __builtin_amdgcn_s_setprio(0); } while (0)
#define PG8_WAIT_V(n) asm volatile("s_waitcnt vmcnt(" #n ")" ::: "memory")
#define PG8_WAIT_L(n) asm volatile("s_waitcnt lgkmcnt(" #n ")" ::: "memory")
#define PG8_BAR __builtin_amdgcn_s_barrier()
#define PG8_SCHED __builtin_amdgcn_sched_barrier(0)
#define PG8_APTR(u) ((const char*)((u).z ? g.A1 : g.A0) + (size_t)(u).pm * tstep)
#define PG8_BPTR(u) ((const char*)((u).z ? g.B1 : g.B0) + (size_t)(u).pn * tstep)
    Unit cur, nxt; int ui = 0;
    if (!Sc.next(0, cur)) return;
    f32x4 acc[2][2][4][2];
#pragma unroll
    for (int a = 0; a < 2; ++a)
#pragma unroll
        for (int b = 0; b < 2; ++b)
#pragma unroll
            for (int m = 0; m < 4; ++m)
#pragma unroll
                for (int n = 0; n < 2; ++n) acc[a][b][m][n] = (f32x4){0.f, 0.f, 0.f, 0.f};
    bf16x8 At[4][2], B0[2][2], B1[2][2];
    const char* cA = PG8_APTR(cur); const char* cB = PG8_BPTR(cur);
    if constexpr (SP2) {
        PG8_STAGE(PG8_SB(0, 0), cB, voffB); PG8_STAGE(PG8_SB(0, 1), cB + hstep, voffB); PG8_STAGE(PG8_SA(0, 0), cA, voffA); PG8_STAGE(PG8_SA(0, 1), cA + hstep, voffA);
        if (wr == 1) PG8_BAR;
        PG8_WAIT_V(2); PG8_BAR;
        PG8_STAGE(PG8_SB(1, 0), cB + kstep, voffB); PG8_STAGE(PG8_SA(1, 0), cA + kstep, voffA); PG8_STAGE(PG8_SB(1, 1), cB + hstep + kstep, voffB);
        PG8_WAIT_V(6); PG8_BAR;
    } else {
        PG8_STAGE(PG8_SB(0, 0), cB, voffB); PG8_STAGE(PG8_SA(0, 0), cA, voffA); PG8_STAGE(PG8_SB(0, 1), cB + hstep, voffB); PG8_STAGE(PG8_SA(0, 1), cA + hstep, voffA);
        if (wr == 1) PG8_BAR;
        PG8_WAIT_V(4); PG8_BAR;
        PG8_STAGE(PG8_SB(1, 0), cB + kstep, voffB); PG8_STAGE(PG8_SA(1, 0), cA + kstep, voffA); PG8_STAGE(PG8_SB(1, 1), cB + hstep + kstep, voffB);
        PG8_WAIT_V(6); PG8_BAR;
    }
    for (;;) {
        const bool has_next = Sc.next(ui + 1, nxt);
        const char* nA = has_next ? PG8_APTR(nxt) : cA; const char* nB = has_next ? PG8_BPTR(nxt) : cB;
        for (int t = 0; t < nt; t += 2) {
            const bool last = (t == nt - 2);
            const char* a1 = cA + (size_t)(t + 1) * kstep;
            const char* a2 = last ? nA : cA + (size_t)(t + 2) * kstep; const char* b2 = last ? nB : cB + (size_t)(t + 2) * kstep;
            const char* a3 = a2 + kstep; const char* b3 = b2 + kstep;
            if constexpr (SP2) {
            PG8_LDB(B0, 0, 0); PG8_LDB(B1, 0, 1); PG8_SCHED; PG8_LDA(At, 0, 0); PG8_STAGE(PG8_SA(1, 1), a1 + hstep, voffA);
            PG8_WAIT_V(8); PG8_WAIT_L(0); PG8_BAR; PG8_MMA(0, 0, At, B0); PG8_MMA(0, 1, At, B1); PG8_BAR; PG8_SCHED;
            PG8_LDA(At, 0, 1); PG8_STAGE(PG8_SB(0, 0), b2, voffB); PG8_STAGE(PG8_SB(0, 1), b2 + hstep, voffB); PG8_STAGE(PG8_SA(0, 0), a2, voffA);
            PG8_WAIT_V(8); PG8_WAIT_L(0); PG8_BAR; PG8_MMA(1, 0, At, B0); PG8_MMA(1, 1, At, B1); PG8_BAR; PG8_SCHED;
            PG8_LDB(B0, 1, 0); PG8_LDB(B1, 1, 1); PG8_SCHED; PG8_LDA(At, 1, 0); PG8_STAGE(PG8_SA(0, 1), a2 + hstep, voffA);
            PG8_WAIT_V(8); PG8_WAIT_L(0); PG8_BAR; PG8_MMA(0, 0, At, B0); PG8_MMA(0, 1, At, B1); PG8_BAR; PG8_SCHED;
            PG8_LDA(At, 1, 1); PG8_STAGE(PG8_SB(1, 0), b3, voffB); PG8_STAGE(PG8_SB(1, 1), b3 + hstep, voffB); PG8_STAGE(PG8_SA(1, 0), a3, voffA);
            PG8_WAIT_V(8); PG8_WAIT_L(0); PG8_BAR; PG8_MMA(1, 0, At, B0); PG8_MMA(1, 1, At, B1); PG8_BAR; PG8_SCHED;
            } else {
            PG8_LDB(B0, 0, 0); PG8_SCHED; PG8_LDA(At, 0, 0); PG8_STAGE(PG8_SA(1, 1), a1 + hstep, voffA);
            PG8_WAIT_L(8); PG8_BAR; PG8_WAIT_L(0); PG8_MMA(0, 0, At, B0); PG8_BAR; PG8_SCHED;
            PG8_LDB(B1, 0, 1); PG8_STAGE(PG8_SB(0, 0), b2, voffB);
            PG8_BAR; PG8_WAIT_L(0); PG8_MMA(0, 1, At, B1); PG8_BAR;
            PG8_LDA(At, 0, 1); PG8_STAGE(PG8_SA(0, 0), a2, voffA);
            PG8_BAR; PG8_WAIT_L(0); PG8_MMA(1, 0, At, B0); PG8_BAR; PG8_SCHED;
            PG8_STAGE(PG8_SB(0, 1), b2 + hstep, voffB);
            PG8_WAIT_V(6); PG8_BAR; PG8_MMA(1, 1, At, B1); PG8_BAR;
            PG8_LDB(B0, 1, 0); PG8_SCHED; PG8_LDA(At, 1, 0); PG8_STAGE(PG8_SA(0, 1), a2 + hstep, voffA);
            PG8_WAIT_L(8); PG8_BAR; PG8_WAIT_L(0); PG8_MMA(0, 0, At, B0); PG8_BAR; PG8_SCHED;
            PG8_LDB(B1, 1, 1); PG8_STAGE(PG8_SB(1, 0), b3, voffB);
            PG8_BAR; PG8_WAIT_L(0); PG8_MMA(0, 1, At, B1); PG8_BAR;
            PG8_LDA(At, 1, 1); PG8_STAGE(PG8_SA(1, 0), a3, voffA);
            PG8_BAR; PG8_WAIT_L(0); PG8_MMA(1, 0, At, B0); PG8_BAR; PG8_SCHED;
            PG8_STAGE(PG8_SB(1, 1), b3 + hstep, voffB);
            PG8_WAIT_V(6); PG8_BAR; PG8_MMA(1, 1, At, B1); PG8_BAR;
            }
        }
        if constexpr (ALIGN_EPI) { if (wr == 0) PG8_BAR; }
        E(acc, cur, wr, wc, fr, fq);
        if (!has_next) break;
#pragma unroll
        for (int a = 0; a < 2; ++a)
#pragma unroll
            for (int b = 0; b < 2; ++b)
#pragma unroll
                for (int m = 0; m < 4; ++m)
#pragma unroll
                    for (int n = 0; n < 2; ++n) acc[a][b][m][n] = (f32x4){0.f, 0.f, 0.f, 0.f};
        cur = nxt; cA = nA; cB = nB; ++ui;
        if constexpr (ALIGN_EPI) { if (wr == 1) PG8_BAR; }
    }
    PG8_WAIT_V(0);
    if constexpr (!ALIGN_EPI) { if (wr == 0) PG8_BAR; }
    PG8_BAR;
#undef PG8_SA
#undef PG8_SB
#undef PG8_STAGE
#undef PG8_LDA
#undef PG8_LDB
#undef PG8_MMA
#undef PG8_WAIT_V
#undef PG8_WAIT_L
#undef PG8_BAR
#undef PG8_SCHED
#undef PG8_APTR
#undef PG8_BPTR
}

typedef const f32x4 (&AccRef)[2][2][4][2];
__device__ __forceinline__ u32x4 pack8_bf16(const f32x4 v0, const f32x4 v1) { u32x4 w; w.x = cvt_pk_bf16(v0[0], v0[1]); w.y = cvt_pk_bf16(v0[2], v0[3]); w.z = cvt_pk_bf16(v1[0], v1[1]); w.w = cvt_pk_bf16(v1[2], v1[3]); return w; }
__device__ __forceinline__ float rinv_ssq(const float* SSQ, int row, int off) {
    const f32x4 a = *(const f32x4*)(SSQ + (size_t)row * 16 + off), b = *(const f32x4*)(SSQ + (size_t)row * 16 + off + 4);
    const float s = ((a[0] + a[1]) + (a[2] + a[3])) + ((b[0] + b[1]) + (b[2] + b[3]));
    return rsqrtf(s * (1.0f / 512.0f) + EPS);
}
__device__ __forceinline__ void rope8(const float2* cs, const f32x4 a0, const f32x4 a1, const f32x4 b0, const f32x4 b1, float sc, u32x4& o1, u32x4& o2) {
    float r1[8], r2[8];
#pragma unroll
    for (int j = 0; j < 8; ++j) { const float2 c = cs[j]; const float x1 = (j < 4 ? a0[j & 3] : a1[j & 3]) * sc, x2 = (j < 4 ? b0[j & 3] : b1[j & 3]) * sc;
        r1[j] = x1 * c.x - x2 * c.y; r2[j] = x2 * c.x + x1 * c.y; }
    o1.x = cvt_pk_bf16(r1[0], r1[1]); o1.y = cvt_pk_bf16(r1[2], r1[3]); o1.z = cvt_pk_bf16(r1[4], r1[5]); o1.w = cvt_pk_bf16(r1[6], r1[7]);
    o2.x = cvt_pk_bf16(r2[0], r2[1]); o2.y = cvt_pk_bf16(r2[2], r2[3]); o2.z = cvt_pk_bf16(r2[4], r2[5]); o2.w = cvt_pk_bf16(r2[6], r2[7]);
}
struct EpiInF { static constexpr bool PERM = true;
    bf16_t *CQ, *CKV, *QNA, *KNA, *VNA, *KM; f16_t *GA, *GB; float *SSQ, *KPER; const float2* CS;
    __device__ __forceinline__ void operator()(AccRef acc, const Unit& u, int wr, int wc, int fr, int fq) const {
        const int pn = u.pn, row0 = u.pm * BM + wr * 64 + fr, cb = wc * 32 + 8 * fq;
        if (pn < 16) {
            bf16_t* base; int ld, c0;
            if (pn < 2) { base = CQ; ld = 512; c0 = pn * 256; } else if (pn < 4) { base = CKV; ld = 512; c0 = (pn - 2) * 256; }
            else if (pn < 8) { base = QNA; ld = 1024; c0 = (pn - 4) * 256; } else if (pn < 12) { base = KNA; ld = 1024; c0 = (pn - 8) * 256; } else { base = VNA; ld = 1024; c0 = (pn - 12) * 256; }
#pragma unroll
            for (int ai = 0; ai < 2; ++ai)
#pragma unroll
                for (int m = 0; m < 4; ++m) { const int row = row0 + ai * HALF + m * 16; float ss = 0.f;
#pragma unroll
                    for (int bj = 0; bj < 2; ++bj) { const f32x4 v0 = acc[ai][bj][m][0], v1 = acc[ai][bj][m][1];
                        *(u32x4*)(base + (size_t)row * ld + c0 + bj * HALF + cb) = pack8_bf16(v0, v1);
                        ss += (v0[0] * v0[0] + v0[1] * v0[1]) + (v0[2] * v0[2] + v0[3] * v0[3]) + (v1[0] * v1[0] + v1[1] * v1[1]) + (v1[2] * v1[2] + v1[3] * v1[3]); }
                    if (pn < 4) { ss += __shfl_xor(ss, 16); ss += __shfl_xor(ss, 32); if (fq == 0) SSQ[(size_t)row * 16 + pn * 4 + wc] = ss; } }
        } else if (pn < 32) {
            f16_t* base = pn < 24 ? GA : GB; const int c0 = (pn < 24 ? pn - 16 : pn - 24) * 256;
#pragma unroll
            for (int ai = 0; ai < 2; ++ai)
#pragma unroll
                for (int m = 0; m < 4; ++m) { const int row = row0 + ai * HALF + m * 16;
#pragma unroll
                    for (int bj = 0; bj < 2; ++bj) { const f32x4 v0 = acc[ai][bj][m][0], v1 = acc[ai][bj][m][1]; u32x4 w;
                        w.x = cvt_pk_f16(sigmoidf(v0[0]), sigmoidf(v0[1])); w.y = cvt_pk_f16(sigmoidf(v0[2]), sigmoidf(v0[3]));
                        w.z = cvt_pk_f16(sigmoidf(v1[0]), sigmoidf(v1[1])); w.w = cvt_pk_f16(sigmoidf(v1[2]), sigmoidf(v1[3]));
                        *(u32x4*)(base + (size_t)row * 2048 + c0 + bj * HALF + cb) = w; } }
        }
    } };
struct EpiQKVF { static constexpr bool PERM = true;
    bf16_t *QM, *KM, *VM; const float* SSQ; const float2* CS;
    __device__ __forceinline__ void operator()(AccRef acc, const Unit& u, int wr, int wc, int fr, int fq) const {
        const int pn = u.pn, z = u.z, row0 = u.pm * BM + wr * 64 + fr, cb = wc * 32 + 8 * fq;
#pragma unroll
        for (int ai = 0; ai < 2; ++ai)
#pragma unroll
            for (int m = 0; m < 4; ++m) { const int row = row0 + ai * HALF + m * 16; const float r = rinv_ssq(SSQ, row, z ? 8 : 0);
                if (z == 0 && pn >= 4) {
                    const int head = 4 * (pn - 4) + wc, i0 = 8 * fq; u32x4 o1, o2;
                    rope8(CS + (size_t)row * 32 + i0, acc[ai][0][m][0], acc[ai][0][m][1], acc[ai][1][m][0], acc[ai][1][m][1], r, o1, o2);
                    bf16_t* q = QM + (size_t)row * 1536 + head * 192 + 128 + i0; *(u32x4*)q = o1; *(u32x4*)(q + 32) = o2;
                } else {
#pragma unroll
                    for (int bj = 0; bj < 2; ++bj) { const f32x4 v0 = acc[ai][bj][m][0] * r, v1 = acc[ai][bj][m][1] * r; bf16_t* dst;
                        if (z == 0) dst = QM + (size_t)row * 1536 + (2 * pn + bj) * 192 + cb;
                        else if (pn < 4) dst = KM + (size_t)row * 1536 + (2 * pn + bj) * 192 + cb;
                        else dst = VM + (size_t)row * 1024 + (2 * (pn - 4) + bj) * 128 + cb;
                        *(u32x4*)dst = pack8_bf16(v0, v1); }
                } }
    } };
struct EpiOF { static constexpr bool PERM = true;
    float* T; const f16_t *GA, *GB; bf16_t* MRG;
    __device__ __forceinline__ void operator()(AccRef acc, const Unit& u, int wr, int wc, int fr, int fq) const {
        const int row0 = u.pm * BM + wr * 64 + fr, cb = u.pn * 256 + wc * 32 + 8 * fq;
#pragma unroll
        for (int ai = 0; ai < 2; ++ai)
#pragma unroll
            for (int m = 0; m < 4; ++m) { const int row = row0 + ai * HALF + m * 16;
#pragma unroll
                for (int bj = 0; bj < 2; ++bj) { const size_t idx = (size_t)row * 2048 + cb + bj * HALF;
                    const u32x4 gw = *(const u32x4*)((u.z ? GB : GA) + idx);
                    const float2 g0 = unpk_f16(gw.x), g1 = unpk_f16(gw.y), g2 = unpk_f16(gw.z), g3 = unpk_f16(gw.w);
                    f32x4 v0 = acc[ai][bj][m][0], v1 = acc[ai][bj][m][1];
                    v0[0] *= g0.x; v0[1] *= g0.y; v0[2] *= g1.x; v0[3] *= g1.y; v1[0] *= g2.x; v1[1] *= g2.y; v1[2] *= g3.x; v1[3] *= g3.y;
                    if (u.z == 0) { *(f32x4*)(T + idx) = v0; *(f32x4*)(T + idx + 4) = v1; }
                    else { v0 += *(const f32x4*)(T + idx); v1 += *(const f32x4*)(T + idx + 4); *(u32x4*)(MRG + idx) = pack8_bf16(v0, v1); } } }
    } };
struct EpiResF { static constexpr bool PERM = true;
    const float* XI; float* XO;
    __device__ __forceinline__ void operator()(AccRef acc, const Unit& u, int wr, int wc, int fr, int fq) const {
        const int row0 = u.pm * BM + wr * 64 + fr, cb = u.pn * 256 + wc * 32 + 8 * fq;
#pragma unroll
        for (int ai = 0; ai < 2; ++ai)
#pragma unroll
            for (int m = 0; m < 4; ++m) { const int row = row0 + ai * HALF + m * 16;
#pragma unroll
                for (int bj = 0; bj < 2; ++bj) { const size_t idx = (size_t)row * 2048 + cb + bj * HALF;
                    const f32x4 x0 = *(const f32x4*)(XI + idx), x1 = *(const f32x4*)(XI + idx + 4);
                    *(f32x4*)(XO + idx) = x0 + acc[ai][bj][m][0]; *(f32x4*)(XO + idx + 4) = x1 + acc[ai][bj][m][1]; } }
    } };
struct EpiFF1F { static constexpr bool PERM = true;
    bf16_t* H;
    __device__ __forceinline__ void operator()(AccRef acc, const Unit& u, int wr, int wc, int fr, int fq) const {
        const int row0 = u.pm * BM + wr * 64 + fr, cb = u.pn * 256 + wc * 32 + 8 * fq;
#pragma unroll
        for (int ai = 0; ai < 2; ++ai)
#pragma unroll
            for (int m = 0; m < 4; ++m) { const int row = row0 + ai * HALF + m * 16;
#pragma unroll
                for (int bj = 0; bj < 2; ++bj) { f32x4 v0 = acc[ai][bj][m][0], v1 = acc[ai][bj][m][1];
#pragma unroll
                    for (int j = 0; j < 4; ++j) { const float a = fmaxf(v0[j], 0.f), b = fmaxf(v1[j], 0.f); v0[j] = a * a; v1[j] = b * b; }
                    *(u32x4*)(H + (size_t)row * DFF + cb + bj * HALF) = pack8_bf16(v0, v1); } }
    } };
}
#ifndef ATT_PIPE
#define ATT_PIPE 0
#endif
namespace att {
typedef short s16x4 __attribute__((ext_vector_type(4)));
typedef float f32x16 __attribute__((ext_vector_type(16)));
constexpr int NW = 8, QBLK = 32, KVBLK = 64;
constexpr float THR = 8.f;
constexpr int SHM_V = KVBLK * 128 * 2;
#define SBAR() __builtin_amdgcn_sched_barrier(0)
#define KSWZ(row, colB, RB) ((row) * (RB) + ((colB) ^ (((row) & 7) << 4)))
__device__ __forceinline__ int crow(int r, int hi) { return (r & 3) + 8 * (r >> 2) + 4 * hi; }
template <int DQ> struct Cfg { static constexpr float SCALE = DQ == 192 ? 0.07216878364870323f : 0.08838834764831845f; static constexpr int RB = DQ * 2, SHM_K = KVBLK * DQ * 2; };

template <int DQ> __device__ __forceinline__ void partialSM(f32x16& p0, f32x16& p1, float& m_reg, float& mn, float& alpha) {
  constexpr float SCALE = Cfg<DQ>::SCALE, C = SCALE * 1.4426950408889634f;
  float pmax = p0[0];
#pragma unroll
  for (int r = 1; r < 16; ++r) pmax = fmaxf(pmax, p0[r]);
#pragma unroll
  for (int r = 0; r < 16; ++r) pmax = fmaxf(pmax, p1[r]);
  { auto rr = __builtin_amdgcn_permlane32_swap(__float_as_uint(pmax), __float_as_uint(pmax), false, false);
    pmax = fmaxf(__uint_as_float(rr[0]), __uint_as_float(rr[1])); }
  if (__builtin_expect(__all(pmax - m_reg <= THR / SCALE), 1)) { mn = m_reg; alpha = 1.f; }
  else { mn = fmaxf(m_reg, pmax); alpha = __builtin_amdgcn_exp2f((m_reg - mn) * C); m_reg = mn; }
  const float mnC = -mn * C;
#pragma unroll
  for (int r = 0; r < 16; ++r) p0[r] = fmaf(p0[r], C, mnC);
#pragma unroll
  for (int r = 0; r < 16; ++r) p1[r] = fmaf(p1[r], C, mnC);
#pragma unroll
  for (int r = 0; r < 16; ++r) p0[r] = __builtin_amdgcn_exp2f(p0[r]);
}
__device__ __forceinline__ void finishSM(f32x16& p0, f32x16& p1, float alpha, float& l_reg, bf16x8& pa0, bf16x8& pa1, bf16x8& pa2, bf16x8& pa3) {
#pragma unroll
  for (int r = 0; r < 16; ++r) p1[r] = __builtin_amdgcn_exp2f(p1[r]);
  float ps = 0;
#pragma unroll
  for (int r = 0; r < 16; ++r) ps += p0[r];
#pragma unroll
  for (int r = 0; r < 16; ++r) ps += p1[r];
  { auto rr = __builtin_amdgcn_permlane32_swap(__float_as_uint(ps), __float_as_uint(ps), false, false);
    ps = __uint_as_float(rr[0]) + __uint_as_float(rr[1]); }
  l_reg = l_reg * alpha + ps;
#define PK4(P, BASE, OUT) do { unsigned a0 = cvt_pk_bf16(P[BASE + 0], P[BASE + 1]), a1 = cvt_pk_bf16(P[BASE + 2], P[BASE + 3]);   \
    unsigned b0 = cvt_pk_bf16(P[BASE + 4], P[BASE + 5]), b1 = cvt_pk_bf16(P[BASE + 6], P[BASE + 7]);                              \
    auto r0 = __builtin_amdgcn_permlane32_swap(a0, b0, false, false); auto r1 = __builtin_amdgcn_permlane32_swap(a1, b1, false, false); \
    u32x4 w = {r0[0], r1[0], r0[1], r1[1]}; OUT = __builtin_bit_cast(bf16x8, w); } while (0)
  PK4(p0, 0, pa0); PK4(p0, 8, pa1); PK4(p1, 0, pa2); PK4(p1, 8, pa3);
#undef PK4
}
template <int DQ> __device__ __forceinline__ void qkt(f32x16& p0, f32x16& p1, const char* Ks, const bf16x8* qr, int r32, int hi) {
  constexpr int RB = Cfg<DQ>::RB;
  p0 = f32x16{}; p1 = f32x16{};
#pragma unroll
  for (int d0 = 0; d0 < DQ / 16; ++d0) { const int cb = (d0 * 16 + hi * 8) * 2;
    const bf16x8 b0 = *reinterpret_cast<const bf16x8*>(Ks + KSWZ(r32, cb, RB));
    const bf16x8 b1 = *reinterpret_cast<const bf16x8*>(Ks + KSWZ(32 + r32, cb, RB));
    p0 = __builtin_amdgcn_mfma_f32_32x32x16_bf16(b0, qr[d0], p0, 0, 0, 0);
    p1 = __builtin_amdgcn_mfma_f32_32x32x16_bf16(b1, qr[d0], p1, 0, 0, 0); }
}
__device__ __forceinline__ int v_st(int k, int c) { const int kk = (k & ~0xC) | ((k & 4) << 1) | ((k & 8) >> 1); return ((kk >> 3) * 4 + (c >> 5)) * 512 + ((kk & 7) * 32 + (c & 31)) * 2; }
__device__ __forceinline__ int v_rd_base(int lane) { return ((lane & 3) << 3) | (((lane >> 2) & 3) << 6) | (((lane >> 4) & 1) << 5) | (((lane >> 5) & 1) << 8); }
constexpr int v_rd_off(int d0, int ks, int half) { return d0 * 512 + ks * 4096 + half * 2048; }
template <int OFF> __device__ __forceinline__ s16x4 tr_read(int vb) {
  s16x4 r; asm volatile("ds_read_b64_tr_b16 %0, %1 offset:%2" : "=&v"(r) : "v"(vb), "i"(OFF) : "memory"); return r;
}
template <int D0> __device__ __forceinline__ void pv_one(f32x16& od, int vb, bf16x8 pa0, bf16x8 pa1, bf16x8 pa2, bf16x8 pa3) {
  const s16x4 l0 = tr_read<v_rd_off(D0, 0, 0)>(vb), h0 = tr_read<v_rd_off(D0, 0, 1)>(vb), l1 = tr_read<v_rd_off(D0, 1, 0)>(vb), h1 = tr_read<v_rd_off(D0, 1, 1)>(vb);
  const s16x4 l2 = tr_read<v_rd_off(D0, 2, 0)>(vb), h2 = tr_read<v_rd_off(D0, 2, 1)>(vb), l3 = tr_read<v_rd_off(D0, 3, 0)>(vb), h3 = tr_read<v_rd_off(D0, 3, 1)>(vb);
  asm volatile("s_waitcnt lgkmcnt(0)" ::: "memory"); SBAR();
#define PK(L, H) (bf16x8){L[0], L[1], L[2], L[3], H[0], H[1], H[2], H[3]}
  od = __builtin_amdgcn_mfma_f32_32x32x16_bf16(pa0, PK(l0, h0), od, 0, 0, 0);
  od = __builtin_amdgcn_mfma_f32_32x32x16_bf16(pa1, PK(l1, h1), od, 0, 0, 0);
  od = __builtin_amdgcn_mfma_f32_32x32x16_bf16(pa2, PK(l2, h2), od, 0, 0, 0);
  od = __builtin_amdgcn_mfma_f32_32x32x16_bf16(pa3, PK(l3, h3), od, 0, 0, 0);
#undef PK
}
__device__ __forceinline__ void pv_d0(f32x16* o, int vb, bf16x8 pa0, bf16x8 pa1, bf16x8 pa2, bf16x8 pa3) {
  pv_one<0>(o[0], vb, pa0, pa1, pa2, pa3); pv_one<1>(o[1], vb, pa0, pa1, pa2, pa3); pv_one<2>(o[2], vb, pa0, pa1, pa2, pa3); pv_one<3>(o[3], vb, pa0, pa1, pa2, pa3);
}
struct NaCtx { const float* btab; int r, qc, cstart, wstart; };
__device__ __forceinline__ void na_mask(f32x16& p0, f32x16& p1, const NaCtx& c, int kr, int hi) {
  const bool inwin = (kr >= c.wstart) && (kr < c.wstart + 8);
  const int dy = min(max(kr - c.r + 7, 0), 14);
#pragma unroll
  for (int r = 0; r < 16; ++r) {
    const int kc0 = crow(r, hi), kc1 = kc0 + 32;
    const bool v0 = inwin && ((unsigned)(kc0 - c.cstart) < 16u), v1 = inwin && ((unsigned)(kc1 - c.cstart) < 16u);
    const int i0 = dy * 31 + min(max(kc0 - c.qc, -15), 15) + 15, i1 = dy * 31 + min(max(kc1 - c.qc, -15), 15) + 15;
    p0[r] = v0 ? p0[r] + c.btab[i0] : -1e30f; p1[r] = v1 ? p1[r] + c.btab[i1] : -1e30f;
  }
}
template <int DQ, bool NA>
__device__ __forceinline__ void attn_unit(const bf16_t* __restrict__ Qb, int ldq, const bf16_t* __restrict__ Kh, int ldk, const bf16_t* __restrict__ Vh, int ldv,
                                          bf16_t* __restrict__ Ob, int ldo, int NT, char* lds, const NaCtx nc, int krow0) {
  constexpr int RB = Cfg<DQ>::RB, SHM_K = Cfg<DQ>::SHM_K, NKC = DQ / 64, CPR = DQ / 8;
  int tid_ = threadIdx.x; asm volatile("" : "+v"(tid_));
  const int tid = tid_, wid = tid >> 6, lane = tid & 63, r32 = lane & 31, hi = lane >> 5;
  char* V_lds = lds; char* K_lds = lds + 2 * SHM_V;
  float* ws = (float*)(lds + 2 * SHM_V + 2 * SHM_K) + wid * 64; float* li_l = ws; float* al_l = ws + 32;
  float m_reg = -1e30f, l_reg = 0; f32x16 o[4] = {}; bf16x8 qr[DQ / 16];
  const bf16_t* Qw = Qb + (long)(wid * QBLK + r32) * ldq + hi * 8;
#pragma unroll
  for (int d0 = 0; d0 < DQ / 16; ++d0) qr[d0] = *reinterpret_cast<const bf16x8*>(Qw + d0 * 16);
  const int sr = tid >> 4, sc = (tid & 15) * 8, vst0 = v_st(sr, sc), vst1 = v_st(32 + sr, sc);
  int krow[NKC], kcol[NKC];
#pragma unroll
  for (int i = 0; i < NKC; ++i) { const int c = tid + 512 * i; krow[i] = c / CPR; kcol[i] = (c % CPR) * 8; }
  const int vb0 = (int)(uintptr_t)V_lds + v_rd_base(lane);
  bf16x8 vs0, vs1, ks[NKC];
#define SLOAD(k0) do { vs0 = *reinterpret_cast<const bf16x8*>(&Vh[(long)((k0) + sr) * ldv + sc]); vs1 = *reinterpret_cast<const bf16x8*>(&Vh[(long)((k0) + 32 + sr) * ldv + sc]); \
    _Pragma("unroll") for (int i_ = 0; i_ < NKC; ++i_) ks[i_] = *reinterpret_cast<const bf16x8*>(&Kh[(long)((k0) + krow[i_]) * ldk + kcol[i_]]); } while (0)
#define SWRITE(b) do { *(bf16x8*)(V_lds + (b) * SHM_V + vst0) = vs0; *(bf16x8*)(V_lds + (b) * SHM_V + vst1) = vs1; \
    _Pragma("unroll") for (int i_ = 0; i_ < NKC; ++i_) *(bf16x8*)(K_lds + (b) * SHM_K + KSWZ(krow[i_], kcol[i_] * 2, RB)) = ks[i_]; } while (0)
#define SWAIT() asm volatile("s_waitcnt vmcnt(0)" ::: "memory")
#define RESC(a) do { if (__any((a) < 1.f)) { if (hi == 0) al_l[r32] = (a); asm volatile("s_waitcnt lgkmcnt(0)" ::: "memory"); \
    _Pragma("unroll") for (int d = 0; d < 4; ++d) _Pragma("unroll") for (int r = 0; r < 16; ++r) o[d][r] *= al_l[crow(r, hi)]; } } while (0)
#define MASK(P0, P1, t) do { if (NA) na_mask(P0, P1, nc, krow0 + (t), hi); } while (0)
#if ATT_PIPE
  f32x16 pA0, pA1, pB0, pB1; float mnA, mnB, alA, alB; bf16x8 pa0, pa1, pa2, pa3;
  SLOAD(0); SWAIT(); SWRITE(0); __syncthreads();
  qkt<DQ>(pA0, pA1, K_lds, qr, r32, hi); MASK(pA0, pA1, 0); partialSM<DQ>(pA0, pA1, m_reg, mnA, alA);
  SLOAD(KVBLK);
  SWAIT(); SWRITE(1); __syncthreads();
  for (int j = 1; j + 1 < NT; j += 2) {
    SBAR(); qkt<DQ>(pB0, pB1, K_lds + SHM_K, qr, r32, hi); MASK(pB0, pB1, j);
    finishSM(pA0, pA1, alA, l_reg, pa0, pa1, pa2, pa3); SBAR();
    SLOAD((j + 1) * KVBLK); SBAR();
    pv_d0(o, vb0, pa0, pa1, pa2, pa3); partialSM<DQ>(pB0, pB1, m_reg, mnB, alB);
    __syncthreads(); SWAIT(); SWRITE(0);
    RESC(alB); __syncthreads();
    SBAR(); qkt<DQ>(pA0, pA1, K_lds, qr, r32, hi); MASK(pA0, pA1, j + 1);
    finishSM(pB0, pB1, alB, l_reg, pa0, pa1, pa2, pa3); SBAR();
    SLOAD((j + 2) * KVBLK); SBAR();
    pv_d0(o, vb0 + SHM_V, pa0, pa1, pa2, pa3); partialSM<DQ>(pA0, pA1, m_reg, mnA, alA);
    __syncthreads(); SWAIT(); SWRITE(1);
    RESC(alA); __syncthreads();
  }
  SBAR(); qkt<DQ>(pB0, pB1, K_lds + SHM_K, qr, r32, hi); MASK(pB0, pB1, NT - 1);
  finishSM(pA0, pA1, alA, l_reg, pa0, pa1, pa2, pa3); SBAR();
  pv_d0(o, vb0, pa0, pa1, pa2, pa3); partialSM<DQ>(pB0, pB1, m_reg, mnB, alB);
  __syncthreads(); RESC(alB);
  finishSM(pB0, pB1, alB, l_reg, pa0, pa1, pa2, pa3); SBAR();
  pv_d0(o, vb0 + SHM_V, pa0, pa1, pa2, pa3);
#else
  f32x16 p0, p1; float mn, al; bf16x8 pa0, pa1, pa2, pa3;
  SLOAD(0); SWAIT(); SWRITE(0); __syncthreads();
  for (int j = 0; j < NT; ++j) {
    const int b = j & 1;
    if (j + 1 < NT) SLOAD((j + 1) * KVBLK);
    SBAR();
    bool act = true;
    if (NA) { const int kr = krow0 + j; act = (kr >= nc.wstart) && (kr < nc.wstart + 8); }
    if (act) {
    qkt<DQ>(p0, p1, K_lds + b * SHM_K, qr, r32, hi); MASK(p0, p1, j);
    partialSM<DQ>(p0, p1, m_reg, mn, al);
    RESC(al);
    finishSM(p0, p1, al, l_reg, pa0, pa1, pa2, pa3); SBAR();
    pv_d0(o, vb0 + b * SHM_V, pa0, pa1, pa2, pa3);
    }
    if (j + 1 < NT) { SWAIT(); SWRITE(b ^ 1); }
    __syncthreads();
  }
#endif
  if (hi == 0) li_l[r32] = l_reg; asm volatile("s_waitcnt lgkmcnt(0)" ::: "memory");
  float rli[16];
#pragma unroll
  for (int r = 0; r < 16; ++r) rli[r] = __builtin_amdgcn_rcpf(li_l[crow(r, hi)]);
  bf16_t* Ow = Ob + (long)(wid * QBLK) * ldo;
  { bf16_t* stg = (bf16_t*)(lds + wid * 8192);
#pragma unroll
    for (int r = 0; r < 16; ++r) { const int orow = crow(r, hi);
#pragma unroll
      for (int d0 = 0; d0 < 4; ++d0) stg[orow * 128 + d0 * 32 + r32] = f2bf(o[d0][r] * rli[r]); }
    asm volatile("s_waitcnt lgkmcnt(0)" ::: "memory");
#pragma unroll
    for (int i = 0; i < 8; ++i) { const int row = i * 4 + (lane >> 4), ch = lane & 15; const u32x4 v = *(const u32x4*)(stg + row * 128 + ch * 8); *(u32x4*)(Ow + (long)row * ldo + ch * 8) = v; } }
  __syncthreads();
#undef SLOAD
#undef SWRITE
#undef SWAIT
#undef RESC
#undef MASK
}
#undef SBAR
}
namespace att2 {
using att::f32x16; using att::s16x4; using att::crow; using att::partialSM; using att::finishSM; using att::pv_d0; using att::v_rd_base; using att::NaCtx; using att::na_mask;
constexpr int KVBLK = 64, QBLK = 32, SLOTV = 16384;
#define SBAR() __builtin_amdgcn_sched_barrier(0)
template <int OFF> __device__ __forceinline__ bf16x8 lds_rd128(int addr) { bf16x8 r; asm volatile("ds_read_b128 %0, %1 offset:%2" : "=v"(r) : "v"(addr), "i"(OFF)); return r; }
template <int DQ> __device__ __forceinline__ void qkt(f32x16& p0, f32x16& p1, LAS const unsigned char* Ks, const int (&kb)[4], const bf16x8* qr) {
  constexpr int N = DQ / 16;
  const int kbase = (int)(uintptr_t)Ks;
  int ka[4];
#pragma unroll
  for (int q = 0; q < 4; ++q) ka[q] = kb[q] + kbase;
  p0 = f32x16{}; p1 = f32x16{};
  bf16x8 f0[3], f1[3];
#define QK_RD(d) do { constexpr int off_ = ((d) >> 2) * 8192; f0[(d) % 3] = lds_rd128<off_>(ka[(d) & 3]); f1[(d) % 3] = lds_rd128<off_ + 4096>(ka[(d) & 3]); } while (0)
  QK_RD(0); QK_RD(1); QK_RD(2);
  __builtin_amdgcn_s_setprio(1);
#define QK_STEP(d) do { \
    if ((d) + 2 < N) asm volatile("s_waitcnt lgkmcnt(4)" : "+v"(f0[(d) % 3]), "+v"(f1[(d) % 3])); \
    else if ((d) + 1 < N) asm volatile("s_waitcnt lgkmcnt(2)" : "+v"(f0[(d) % 3]), "+v"(f1[(d) % 3])); \
    else asm volatile("s_waitcnt lgkmcnt(0)" : "+v"(f0[(d) % 3]), "+v"(f1[(d) % 3])); \
    p0 = __builtin_amdgcn_mfma_f32_32x32x16_bf16(f0[(d) % 3], qr[d], p0, 0, 0, 0); \
    p1 = __builtin_amdgcn_mfma_f32_32x32x16_bf16(f1[(d) % 3], qr[d], p1, 0, 0, 0); \
    if ((d) + 3 < N) { QK_RD((d) + 3); } } while (0)
  QK_STEP(0); QK_STEP(1); QK_STEP(2); QK_STEP(3); QK_STEP(4); QK_STEP(5); QK_STEP(6); QK_STEP(7);
  if constexpr (N > 8) { QK_STEP(8); QK_STEP(9); QK_STEP(10); QK_STEP(11); }
#undef QK_STEP
#undef QK_RD
  __builtin_amdgcn_s_setprio(0);
}
template <int DQ> struct L { static constexpr int SLOTK = KVBLK * DQ * 2, VBASE = 4 * SLOTK, WSOFF = VBASE + 3 * SLOTV, BYTES = WSOFF + 2048; };
template <int DQ, bool NA>
__device__ __forceinline__ void attn_unit(const bf16_t* __restrict__ Qb, int ldq, const bf16_t* __restrict__ Kh, int ldk, const bf16_t* __restrict__ Vh, int ldv,
                                          bf16_t* __restrict__ Ob, int ldo, int NT, LAS unsigned char* lds, const NaCtx nc, int krow0) {
  constexpr int SLOTK = L<DQ>::SLOTK, VBASE = L<DQ>::VBASE, NKC = DQ / 64;
  int tid_ = threadIdx.x; asm volatile("" : "+v"(tid_));
  const int tid = tid_, wid = __builtin_amdgcn_readfirstlane(tid >> 6), lane = tid & 63, r32 = lane & 31, hi = lane >> 5;
  LAS float* ws = (LAS float*)(lds + L<DQ>::WSOFF) + wid * 64; LAS float* li_l = ws; LAS float* al_l = ws + 32;
  float m_reg = -1e30f, l_reg = 0; f32x16 o[4] = {}; bf16x8 qr[DQ / 16];
  const bf16_t* Qw = Qb + (long)(wid * QBLK + r32) * ldq + hi * 8;
#pragma unroll
  for (int d0 = 0; d0 < DQ / 16; ++d0) qr[d0] = *reinterpret_cast<const bf16x8*>(Qw + d0 * 16);
  const int krow = 8 * wid + (lane >> 3), kch = (lane & 7) ^ ((krow >> 1) & 7);
  const bf16_t* kg0 = Kh + (long)krow * ldk + kch * 8;
  const int vkk = (wid >> 1) * 8 + ((lane & 31) >> 2), vkey = (vkk & ~0xC) | ((vkk & 4) << 1) | ((vkk & 8) >> 1), vcol = (2 * (wid & 1) + hi) * 32 + (lane & 3) * 8;
  const bf16_t* vg0 = Vh + (long)vkey * ldv + vcol;
  const unsigned wsl = (unsigned)wid * 1024u;
#define DMA_K(t, slot) do { const bf16_t* kg_ = kg0 + (long)(t) * KVBLK * ldk; \
    _Pragma("unroll") for (int i_ = 0; i_ < NKC; ++i_) __builtin_amdgcn_global_load_lds((const unsigned*)(kg_ + i_ * 64), (LAS unsigned*)(lds + (slot) * SLOTK + i_ * 8192 + wsl), 16, 0, 0); } while (0)
#define DMA_V(t, slot) do { const bf16_t* vg_ = vg0 + (long)(t) * KVBLK * ldv; \
    __builtin_amdgcn_global_load_lds((const unsigned*)(vg_), (LAS unsigned*)(lds + VBASE + (slot) * SLOTV + wsl), 16, 0, 0); \
    __builtin_amdgcn_global_load_lds((const unsigned*)(vg_ + 32 * (long)ldv), (LAS unsigned*)(lds + VBASE + (slot) * SLOTV + 8192 + wsl), 16, 0, 0); } while (0)
#define WAIT_BARN(full) do { if (full) { if (NKC == 3) asm volatile("s_waitcnt vmcnt(5) lgkmcnt(0)" ::: "memory"); else asm volatile("s_waitcnt vmcnt(4) lgkmcnt(0)" ::: "memory"); } \
    else asm volatile("s_waitcnt vmcnt(0) lgkmcnt(0)" ::: "memory"); __builtin_amdgcn_s_barrier(); asm volatile("" ::: "memory"); } while (0)
#define WAIT_BAR() do { asm volatile("s_waitcnt vmcnt(0) lgkmcnt(0)" ::: "memory"); __builtin_amdgcn_s_barrier(); asm volatile("" ::: "memory"); } while (0)
  int kb[4];
  { const int sw = (r32 >> 1) & 7, u = sw >> 1, t = hi ^ (sw & 1);
#pragma unroll
    for (int q = 0; q < 4; ++q) kb[q] = r32 * 128 + ((((q ^ u) * 2) + t) << 4); }
  const int vb0 = (int)(uintptr_t)(lds + VBASE) + v_rd_base(lane);
#define RESC(a) do { if (__any((a) < 1.f)) { if (hi == 0) al_l[r32] = (a); asm volatile("s_waitcnt lgkmcnt(0)" ::: "memory"); \
    _Pragma("unroll") for (int d = 0; d < 4; ++d) _Pragma("unroll") for (int r = 0; r < 16; ++r) o[d][r] *= al_l[crow(r, hi)]; } } while (0)
#define MASK(P0, P1, t) do { if (NA) na_mask(P0, P1, nc, krow0 + (t), hi); } while (0)
#define NEXT3(s) ((s) == 2 ? 0 : (s) + 1)
  f32x16 pA0, pA1, pB0, pB1; float mnA, mnB, alA, alB; bf16x8 pa0, pa1, pa2, pa3;
  DMA_K(0, 0); DMA_K(1, 1); DMA_V(0, 0); WAIT_BAR();
  DMA_K(2, 2); DMA_V(1, 1);
  qkt<DQ>(pA0, pA1, lds, kb, qr); MASK(pA0, pA1, 0); partialSM<DQ>(pA0, pA1, m_reg, mnA, alA);
  int kc = 1, kn = 3, vp = 0, vn = 2;
#define ADV() do { kc = (kc + 1) & 3; kn = (kn + 1) & 3; vp = (vp == 2 ? 0 : vp + 1); vn = (vn == 2 ? 0 : vn + 1); } while (0)
  for (int j = 1; j + 1 < NT; j += 2) {
    { const bool full = j + 2 < NT; if (full) { DMA_K(j + 2, kn); } DMA_V(j + 1, vn);
      SBAR(); qkt<DQ>(pB0, pB1, lds + kc * SLOTK, kb, qr); MASK(pB0, pB1, j);
      finishSM(pA0, pA1, alA, l_reg, pa0, pa1, pa2, pa3); SBAR();
      pv_d0(o, vb0 + vp * SLOTV, pa0, pa1, pa2, pa3); partialSM<DQ>(pB0, pB1, m_reg, mnB, alB);
      RESC(alB); WAIT_BARN(full); ADV(); }
    { const bool full = j + 3 < NT; if (full) { DMA_K(j + 3, kn); } DMA_V(j + 2, vn);
      SBAR(); qkt<DQ>(pA0, pA1, lds + kc * SLOTK, kb, qr); MASK(pA0, pA1, j + 1);
      finishSM(pB0, pB1, alB, l_reg, pa0, pa1, pa2, pa3); SBAR();
      pv_d0(o, vb0 + vp * SLOTV, pa0, pa1, pa2, pa3); partialSM<DQ>(pA0, pA1, m_reg, mnA, alA);
      RESC(alA); WAIT_BARN(full); ADV(); }
  }
  SBAR(); qkt<DQ>(pB0, pB1, lds + kc * SLOTK, kb, qr); MASK(pB0, pB1, NT - 1);
  finishSM(pA0, pA1, alA, l_reg, pa0, pa1, pa2, pa3); SBAR();
  pv_d0(o, vb0 + vp * SLOTV, pa0, pa1, pa2, pa3); partialSM<DQ>(pB0, pB1, m_reg, mnB, alB);
  RESC(alB);
  finishSM(pB0, pB1, alB, l_reg, pa0, pa1, pa2, pa3); SBAR();
  pv_d0(o, vb0 + (vp == 2 ? 0 : vp + 1) * SLOTV, pa0, pa1, pa2, pa3);
  if (hi == 0) li_l[r32] = l_reg; asm volatile("s_waitcnt lgkmcnt(0)" ::: "memory");
  float rli[16];
#pragma unroll
  for (int r = 0; r < 16; ++r) rli[r] = __builtin_amdgcn_rcpf(li_l[crow(r, hi)]);
  bf16_t* Ow = Ob + (long)(wid * QBLK) * ldo;
  { if (((NT - 1) & 3) != 3) WAIT_BAR();
    LAS bf16_t* stg = (LAS bf16_t*)(lds + wid * 8192);
#pragma unroll
    for (int r = 0; r < 16; ++r) { const int orow = crow(r, hi);
#pragma unroll
      for (int d0 = 0; d0 < 4; ++d0) stg[orow * 128 + d0 * 32 + r32] = f2bf(o[d0][r] * rli[r]); }
    asm volatile("s_waitcnt lgkmcnt(0)" ::: "memory");
#pragma unroll
    for (int i = 0; i < 8; ++i) { const int row = i * 4 + (lane >> 4), ch = lane & 15; const u32x4 v = *(const LAS u32x4*)(stg + row * 128 + ch * 8); *(u32x4*)(Ow + (long)row * ldo + ch * 8) = v; } }
  WAIT_BAR();
#undef DMA_K
#undef DMA_V
#undef WAIT_BARN
#undef ADV
#undef WAIT_BAR
#undef RESC
#undef MASK
#undef NEXT3
}
#undef SBAR
}
#define XB_TMO      128
#define XB_XCNT(j)  (256  + 64 * (j))
#define XB_XSUB(j)  (1280 + 64 * (j))
#define XB_XGEN(j)  (2304 + 64 * (j))
#define XB_TOP      3328
#define XB_TOPGEN   3392
#define XCD_BAR_WORDS 3456
#define XB_SPIN_CAP (1u << 18)
constexpr size_t OFF_BAR = 23 * MiB;
__device__ __forceinline__ unsigned xb_ld(unsigned* p)              { return __hip_atomic_load(p, __ATOMIC_RELAXED, __HIP_MEMORY_SCOPE_AGENT); }
__device__ __forceinline__ unsigned xb_add(unsigned* p, unsigned v) { return __hip_atomic_fetch_add(p, v, __ATOMIC_RELAXED, __HIP_MEMORY_SCOPE_AGENT); }
__device__ __forceinline__ unsigned xb_xcc_id() { return (unsigned)__builtin_amdgcn_s_getreg((3 << 11) | 20) & 0xFu; }
#define XB_SPIN(cond, bar) do { unsigned _sp = 0; while (cond) { __builtin_amdgcn_s_sleep(1); \
    if ((++_sp & 255u) == 0u) { if (xb_ld(&(bar)[XB_TMO])) break; if (_sp > XB_SPIN_CAP) { atomicAdd(&(bar)[XB_TMO], 1u); break; } } } } while (0)
struct XcdBarrier { unsigned* bar; unsigned x; volatile LAS unsigned* st; };
__device__ __forceinline__ XcdBarrier xcd_barrier_post(unsigned* bar, volatile LAS unsigned* st) {
    XcdBarrier b; b.bar = bar; b.x = xb_xcc_id(); b.st = st;
    if (threadIdx.x == 0) (void)xb_add(&bar[XB_XCNT(b.x)], 1u);
    return b;
}
__device__ __forceinline__ void xcd_barrier_complete(unsigned* bar, unsigned x, unsigned& nloc, unsigned& nx) {
    const unsigned G = gridDim.x * gridDim.y * gridDim.z;
    unsigned sum, cnt, mine, sp = 0u;
    for (;;) {
        sum = 0u; cnt = 0u; mine = 0u;
#pragma unroll
        for (unsigned j = 0; j < 16; ++j) { const unsigned c = xb_ld(&bar[XB_XCNT(j)]); sum += c; cnt += (c > 0u) ? 1u : 0u; mine = (j == x) ? c : mine; }
        if (sum == G) break;
        __builtin_amdgcn_s_sleep(1);
        if ((++sp & 255u) == 0u) { if (xb_ld(&bar[XB_TMO])) break; if (sp > XB_SPIN_CAP) { atomicAdd(&bar[XB_TMO], 1u); break; } }
    }
    nloc = mine > 0u ? mine : 1u; nx = cnt > 0u ? cnt : 1u;
}
__device__ __forceinline__ void xcd_barrier(const XcdBarrier& b) {
    asm volatile("s_waitcnt vmcnt(0)" ::: "memory");
    __syncthreads();
    if (threadIdx.x == 0) {
        unsigned* bar = b.bar;
        __builtin_amdgcn_s_waitcnt(0);
        unsigned nloc = b.st[0], nx = b.st[1];
        if (nloc == 0u) { xcd_barrier_complete(bar, b.x, nloc, nx); b.st[0] = nloc; b.st[1] = nx; }
        const unsigned old = xb_add(&bar[XB_XSUB(b.x)], 1u);
        const unsigned gen = old / nloc;
        if (old + 1u == (gen + 1u) * nloc) {
            __builtin_amdgcn_fence(__ATOMIC_RELEASE, "agent");
            asm volatile("s_waitcnt vmcnt(0)" ::: "memory");
            const unsigned og = xb_add(&bar[XB_TOP], 1u);
            const unsigned tg = og / nx;
            if (og + 1u == (tg + 1u) * nx) xb_add(&bar[XB_TOPGEN], 1u);
            else XB_SPIN(xb_ld(&bar[XB_TOPGEN]) == tg, bar);
            __builtin_amdgcn_fence(__ATOMIC_ACQUIRE, "agent");
            xb_add(&bar[XB_XGEN(b.x)], 1u);
            asm volatile("s_waitcnt vmcnt(0)" ::: "memory");
        } else {
            XB_SPIN(xb_ld(&bar[XB_XGEN(b.x)]) == gen, bar);
            __builtin_amdgcn_fence(__ATOMIC_ACQUIRE, "agent");
            asm volatile("s_waitcnt vmcnt(0)" ::: "memory");
        }
    }
    __syncthreads();
}
constexpr int LDS_BYTES = 151616;
constexpr int LDS_BTAB = 149504, LDS_BARST = 149504 + 2048;
constexpr int NPH = 38;
#define LDS_WAIT() asm volatile("s_waitcnt lgkmcnt(0)" ::: "memory")

__device__ __forceinline__ int drow_map(int kind, int n) {
    if (kind == 0) { if (n < 1024) return n; if (n < 1088) return 8192 + (n - 1024); return n - 64; }
    if (kind == 1) { const int h = n / 192, j = n % 192; if (j < 128) return h * 128 + j; if (j < 160) return 1024 + 256 * (h >> 2) + (h & 3) * 32 + (j - 128); return 1024 + 256 * (h >> 2) + 128 + (h & 3) * 32 + (j - 160); }
    if (kind == 2) { const int h = n / 256, j = n % 256; if (j < 128) return h * 128 + j; return 1024 + h * 128 + (j - 128); }
    return n;
}
struct TrItem { const float* src; const float* gain; bf16_t* dst; int N, K; };
__device__ __forceinline__ bool tr_decode(const Args& a, int it, TrItem& t) {
    constexpr int PER_LAYER = 29632;
    if (it >= DEPTH * PER_LAYER) return false;
    const int l = it / PER_LAYER; int r = it % PER_LAYER;
    unsigned char* wl = a.ws + OFF_W + (size_t)l * WL_STRIDE;
    const float* W; int K, N, kind = 3; bf16_t* WT; const float* gain = nullptr;
    if (r < 8256) { W = a.in[I_WIN] + (size_t)l * DM * INT; K = 2048; N = INT; WT = (bf16_t*)(wl + WL_IN); kind = 0; }
    else if ((r -= 8256) < 384) { W = a.in[I_WUQ] + (size_t)l * 512 * 1536; K = 512; N = 1536; WT = (bf16_t*)(wl + WL_UQ); kind = 1; gain = a.in[I_NQA] + (size_t)l * 512; }
    else if ((r -= 384) < 512) { W = a.in[I_WUKV] + (size_t)l * 512 * 2048; K = 512; N = 2048; WT = (bf16_t*)(wl + WL_UKV); kind = 2; gain = a.in[I_NKVA] + (size_t)l * 512; }
    else if ((r -= 512) < 1024) { W = a.in[I_WOA] + (size_t)l * 1024 * 2048; K = 1024; N = 2048; WT = (bf16_t*)(wl + WL_OA); }
    else if ((r -= 1024) < 1024) { W = a.in[I_WOB] + (size_t)l * 1024 * 2048; K = 1024; N = 2048; WT = (bf16_t*)(wl + WL_OB); }
    else if ((r -= 1024) < 2048) { W = a.in[I_WOUT] + (size_t)l * 2048 * 2048; K = 2048; N = 2048; WT = (bf16_t*)(wl + WL_OUT); }
    else if ((r -= 2048) < 8192) { W = a.in[I_WFF1] + (size_t)l * DM * DFF; K = 2048; N = DFF; WT = (bf16_t*)(wl + WL_FF1); }
    else { r -= 8192; W = a.in[I_WFF2] + (size_t)l * DFF * DM; K = DFF; N = 2048; WT = (bf16_t*)(wl + WL_FF2); }
    const int nblk = N / 32, kb = r / nblk, nb = r % nblk, k0 = kb * 64, n0 = nb * 32;
    t.src = W + (size_t)k0 * N + n0; t.gain = gain ? gain + k0 : nullptr; t.dst = WT + (size_t)drow_map(kind, n0) * K + k0; t.N = N; t.K = K; return true;
}
__device__ __forceinline__ void tr_load(const TrItem& t, f32x4 (&v)[8], float (&gv)[8], int lane) {
#pragma unroll
    for (int i = 0; i < 8; ++i) { const int kk = 8 * i + (lane >> 3); v[i] = *(const f32x4*)(t.src + (size_t)kk * t.N + (lane & 7) * 4); gv[i] = t.gain ? t.gain[kk] : 1.0f; }
}
__device__ __forceinline__ void tr_store(const TrItem& t, const f32x4 (&v)[8], const float (&gv)[8], LAS float* scr, int lane) {
#pragma unroll
    for (int i = 0; i < 8; ++i) { const int kk = 8 * i + (lane >> 3); const f32x4 x = v[i] * gv[i];
        LAS float* d = scr + kk * 33 + (lane & 7) * 4; d[0] = x[0]; d[1] = x[1]; d[2] = x[2]; d[3] = x[3]; }
    LDS_WAIT(); asm volatile("" ::: "memory");
    const int c = lane & 7;
#pragma unroll
    for (int j = 0; j < 4; ++j) { const int n = (lane >> 3) + 8 * j; const LAS float* s = scr + (8 * c) * 33 + n;
        u32x4 o; o.x = cvt_pk_bf16(s[0 * 33], s[1 * 33]); o.y = cvt_pk_bf16(s[2 * 33], s[3 * 33]); o.z = cvt_pk_bf16(s[4 * 33], s[5 * 33]); o.w = cvt_pk_bf16(s[6 * 33], s[7 * 33]);
        *(u32x4*)(t.dst + (size_t)n * t.K + 8 * c) = o; }
    LDS_WAIT(); asm volatile("" ::: "memory");
}
__device__ __forceinline__ void prologue(const Args& a, LAS unsigned char* lds) {
    int tid_ = threadIdx.x; asm volatile("" : "+v"(tid_));
    const int tid = tid_, lane = tid & 63, wave = tid >> 6, G = gridDim.x;
    float2* CS = (float2*)(a.ws + OFF_CS);
    for (int idx = blockIdx.x * 512 + tid; idx < S * 32; idx += G * 512) { const int pos = idx >> 5, i = idx & 31; float c, s; sincos_acc((float)pos * inv_freq(i), c, s); CS[idx] = make_float2(c, s); }
    LAS float* scr = (LAS float*)(lds + wave * 8448);
    const int gw = blockIdx.x * 8 + wave, NGW = G * 8;
    TrItem cur, nxt; f32x4 v[8], vn[8]; float gv[8], gn[8];
    bool have = tr_decode(a, gw, cur);
    if (have) tr_load(cur, v, gv, lane);
    for (int it = gw; have; it += NGW) {
        const bool hn = tr_decode(a, it + NGW, nxt);
        if (hn) tr_load(nxt, vn, gn, lane);
        tr_store(cur, v, gv, scr, lane);
        cur = nxt; have = hn;
#pragma unroll
        for (int i = 0; i < 8; ++i) { v[i] = vn[i]; gv[i] = gn[i]; }
    }
}
template <bool F32OUT>
__device__ __forceinline__ void norm_phase(const float* X, const float* g, bf16_t* Ub, float* Of) {
    int tid_ = threadIdx.x; asm volatile("" : "+v"(tid_));
    const int lane = tid_ & 63, gw = blockIdx.x * 8 + (tid_ >> 6), NGW = gridDim.x * 8;
    for (int row = gw; row < S; row += NGW) {
        const f32x4* xr = (const f32x4*)(X + (size_t)row * DM);
        f32x4 v[8]; float ss = 0.f;
#pragma unroll
        for (int j = 0; j < 8; ++j) { v[j] = xr[lane + 64 * j]; ss += (v[j][0] * v[j][0] + v[j][1] * v[j][1]) + (v[j][2] * v[j][2] + v[j][3] * v[j][3]); }
#pragma unroll
        for (int o = 1; o < 64; o <<= 1) ss += __shfl_xor(ss, o);
        const float rinv = rsqrtf(ss * (1.0f / DM) + EPS);
        const f32x4* gr = (const f32x4*)g;
#pragma unroll
        for (int j = 0; j < 8; ++j) { const f32x4 o = v[j] * rinv * gr[lane + 64 * j];
            if (F32OUT) ((f32x4*)(Of + (size_t)row * DM))[lane + 64 * j] = o;
            else ((uint2*)(Ub + (size_t)row * DM))[lane + 64 * j] = make_uint2(cvt_pk_bf16(o[0], o[1]), cvt_pk_bf16(o[2], o[3])); }
    }
}
__device__ __forceinline__ void norm_kpe_phase(const float* X, const float* g, bf16_t* Ub, const bf16_t* Wk, const float2* CS, bf16_t* KM, LAS unsigned char* lds) {
    constexpr int PITCH = 4096 + 16;
    int tid_ = threadIdx.x; asm volatile("" : "+v"(tid_));
    const int tid = tid_, lane = tid & 63, wid = tid >> 6, r32 = lane & 31, hi = lane >> 5;
    for (int rb = blockIdx.x; rb < S / 32; rb += gridDim.x) {
        const int base = rb * 32;
#pragma unroll 1
        for (int rr = 0; rr < 4; ++rr) { const int lr = 4 * wid + rr, row = base + lr;
            const f32x4* xr = (const f32x4*)(X + (size_t)row * DM); f32x4 v[8]; float ss = 0.f;
#pragma unroll
            for (int j = 0; j < 8; ++j) { v[j] = xr[lane + 64 * j]; ss += (v[j][0] * v[j][0] + v[j][1] * v[j][1]) + (v[j][2] * v[j][2] + v[j][3] * v[j][3]); }
#pragma unroll
            for (int o = 1; o < 64; o <<= 1) ss += __shfl_xor(ss, o);
            const float rinv = rsqrtf(ss * (1.0f / DM) + EPS); const f32x4* gr = (const f32x4*)g;
#pragma unroll
            for (int j = 0; j < 8; ++j) { const f32x4 o = v[j] * rinv * gr[lane + 64 * j]; typedef unsigned u32x2 __attribute__((ext_vector_type(2))); const u32x2 w = {cvt_pk_bf16(o[0], o[1]), cvt_pk_bf16(o[2], o[3])};
                ((u32x2*)(Ub + (size_t)row * DM))[lane + 64 * j] = w; *(LAS u32x2*)(lds + lr * PITCH + (lane + 64 * j) * 8) = w; } }
        __syncthreads();
        att::f32x16 a0 = {}, a1 = {};
#pragma unroll 4
        for (int ks = 0; ks < 16; ++ks) { const int k0 = 256 * wid + 16 * ks + hi * 8;
            const bf16x8 w0 = *(const bf16x8*)(Wk + (size_t)r32 * 2048 + k0), w1 = *(const bf16x8*)(Wk + (size_t)(32 + r32) * 2048 + k0);
            const bf16x8 uu = *(const LAS bf16x8*)(lds + r32 * PITCH + k0 * 2);
            a0 = __builtin_amdgcn_mfma_f32_32x32x16_bf16(w0, uu, a0, 0, 0, 0); a1 = __builtin_amdgcn_mfma_f32_32x32x16_bf16(w1, uu, a1, 0, 0, 0); }
        __syncthreads();
        LAS float* P = (LAS float*)lds;
#pragma unroll
        for (int r = 0; r < 16; ++r) { P[(wid * 32 + r) * 64 + lane] = a0[r]; P[(wid * 32 + 16 + r) * 64 + lane] = a1[r]; }
        __syncthreads();
#pragma unroll
        for (int rr = 0; rr < 2; ++rr) { const int r = 2 * wid + rr; float x1 = 0.f, x2 = 0.f;
#pragma unroll
            for (int w = 0; w < 8; ++w) { x1 += P[(w * 32 + r) * 64 + lane]; x2 += P[(w * 32 + 16 + r) * 64 + lane]; }
            const int row = base + r32, i = att::crow(r, hi); const float2 cs = CS[(size_t)row * 32 + i];
            const bf16_t o1 = f2bf(x1 * cs.x - x2 * cs.y), o2 = f2bf(x2 * cs.x + x1 * cs.y);
            bf16_t* kr = KM + (size_t)row * 1536 + 128 + i;
#pragma unroll
            for (int h = 0; h < 8; ++h) { kr[h * 192] = o1; kr[h * 192 + 32] = o2; } }
        __syncthreads();
    }
}
#ifndef ATT_V2
#define ATT_V2 1
#endif
#if ATT_V2
#define ATTNS att2
#define ATT_LDS(p) ((LAS unsigned char*)(p))
#else
#define ATTNS att
#define ATT_LDS(p) ((char*)(p))
#endif
__device__ __forceinline__ void attn_phase(const Args& a, int l, unsigned char* lds) {
    unsigned char* ws = a.ws; asm volatile("" : "+s"(ws));
    int tid_ = threadIdx.x; asm volatile("" : "+v"(tid_));
    const int c = blockIdx.x, G = gridDim.x, tid = tid_, wid = tid >> 6, r32 = tid & 31;
    const att::NaCtx nc0{nullptr, 0, 0, 0, 0};
#ifndef NO_MLA
    for (int uidx = c; uidx < 256; uidx += G) { const int h = uidx & 7, qb = uidx >> 3;
        ATTNS::attn_unit<192, false>((const bf16_t*)(ws + OFF_QM) + (size_t)qb * 256 * 1536 + h * 192, 1536, (const bf16_t*)(ws + OFF_KM) + h * 192, 1536,
                                   (const bf16_t*)(ws + OFF_VM) + h * 128, 1024, (bf16_t*)(ws + OFF_ATA) + (size_t)qb * 256 * 1024 + h * 128, 1024, S / 64, ATT_LDS(lds), nc0, 0); }
#endif
#ifndef NO_NA
    float* btab = (float*)(lds + LDS_BTAB);
    for (int uidx = c; uidx < 256; uidx += G) { const int h = uidx & 7, g4 = uidx >> 3, r0 = 4 * g4, kr0 = min(max(r0 - 4, 0), 116);
        __syncthreads();
        if (tid < 465) btab[tid] = a.in[I_RPB][((size_t)l * 8 + h) * 465 + tid] * 11.313708498984761f;
        __syncthreads();
        att::NaCtx nc; nc.btab = btab; nc.r = r0 + (wid >> 1); nc.qc = (wid & 1) * 32 + r32; nc.cstart = min(max(nc.qc - 8, 0), 48); nc.wstart = min(max(nc.r - 4, 0), 120);
        att::attn_unit<128, true>((const bf16_t*)(ws + OFF_QNA) + (size_t)r0 * 64 * 1024 + h * 128, 1024, (const bf16_t*)(ws + OFF_KNA) + (size_t)kr0 * 64 * 1024 + h * 128, 1024,
                                  (const bf16_t*)(ws + OFF_VNA) + (size_t)kr0 * 64 * 1024 + h * 128, 1024, (bf16_t*)(ws + OFF_ATB) + (size_t)r0 * 64 * 1024 + h * 128, 1024, 12, (char*)lds, nc, kr0); }
#endif
}
#ifndef ONLY
#define ONLY -1
#endif
#define PHS(k) (ONLY < 0 || ONLY == (k))
__global__ void __launch_bounds__(512) mega(Args a) {
    extern __shared__ __attribute__((aligned(16))) unsigned char lds[];
    cg::grid_group grid = cg::this_grid();
    LAS unsigned char* ldsl = (LAS unsigned char*)lds;
    const int G = gridDim.x, c = blockIdx.x;
    volatile LAS unsigned* bst = (volatile LAS unsigned*)(ldsl + LDS_BARST);
    if (threadIdx.x < 2) bst[threadIdx.x] = 0u;
    __syncthreads();
    XcdBarrier xbar; xbar.bar = (unsigned*)(a.ws + OFF_BAR); xbar.x = 0; xbar.st = bst;
    if (a.ph_hi - a.ph_lo > 1) xbar = xcd_barrier_post((unsigned*)(a.ws + OFF_BAR), bst);
#define GRID_BAR() xcd_barrier(xbar)
#ifdef REPEAT_PRO
    if (a.ph_lo == 0) { prologue(a, ldsl); grid.sync(); }
#endif
    if (PHS(100) && a.ph_lo == 0) { prologue(a, ldsl); if (a.ph_hi > 1) grid.sync(); }
    const int plo = a.ph_lo < 1 ? 1 : a.ph_lo, phi = a.ph_hi > NPH - 1 ? NPH - 1 : a.ph_hi;
    for (int ph = plo; ph < phi; ++ph) {
#ifdef REPEAT_K
        for (int rep = 0; rep < (((ph - 1) % 9 == REPEAT_K) ? 2 : 1); ++rep) {
            if (rep) GRID_BAR();
#else
        {
#endif
            unsigned char* ws = a.ws; asm volatile("" : "+s"(ws));
            const int l = (ph - 1) / 9, k = (ph - 1) % 9;
            const float* xin = (l == 0) ? a.in[I_X] : a.out;
            unsigned char* wl = ws + OFF_W + (size_t)l * WL_STRIDE;
            if (PHS(0) && k == 0) norm_kpe_phase(xin, a.in[I_NMIX] + (size_t)l * DM, (bf16_t*)(ws + OFF_U), (const bf16_t*)(wl + WL_IN) + (size_t)8192 * 2048, (const float2*)(ws + OFF_CS), (bf16_t*)(ws + OFF_KM), ldsl);
            else if (PHS(1) && k == 1) {
                pg8::Gemm g{(const bf16_t*)(ws + OFF_U), nullptr, (const bf16_t*)(wl + WL_IN), nullptr, 2048}; pg8::StaticOrder so; so.init(S, 8192, G, c);
                pg8::EpiInF E{(bf16_t*)(ws + OFF_CQ), (bf16_t*)(ws + OFF_CKV), (bf16_t*)(ws + OFF_QNA), (bf16_t*)(ws + OFF_KNA), (bf16_t*)(ws + OFF_VNA), (bf16_t*)(ws + OFF_KM),
                              (f16_t*)(ws + OFF_GA), (f16_t*)(ws + OFF_GB), (float*)(ws + OFF_SSQ), (float*)(ws + OFF_KPER), (const float2*)(ws + OFF_CS)};
                pg8::gemm_phase<pg8::EpiInF, pg8::StaticOrder>(ldsl, g, so, E);
            } else if (PHS(2) && k == 2) {
                pg8::Gemm g{(const bf16_t*)(ws + OFF_CQ), (const bf16_t*)(ws + OFF_CKV), (const bf16_t*)(wl + WL_UQ), (const bf16_t*)(wl + WL_UKV), 512}; pg8::SchedQKV sq; sq.init(G, c);
                pg8::EpiQKVF E{(bf16_t*)(ws + OFF_QM), (bf16_t*)(ws + OFF_KM), (bf16_t*)(ws + OFF_VM), (const float*)(ws + OFF_SSQ), (const float2*)(ws + OFF_CS)};
                pg8::gemm_phase<pg8::EpiQKVF, pg8::SchedQKV>(ldsl, g, sq, E);
            } else if (PHS(3) && k == 3) attn_phase(a, l, lds);
            else if (PHS(4) && k == 4) {
                pg8::Gemm g{(const bf16_t*)(ws + OFF_ATA), (const bf16_t*)(ws + OFF_ATB), (const bf16_t*)(wl + WL_OA), (const bf16_t*)(wl + WL_OB), 1024}; pg8::SchedO sq; sq.init(G, c);
                pg8::EpiOF E{(float*)(ws + OFF_T), (const f16_t*)(ws + OFF_GA), (const f16_t*)(ws + OFF_GB), (bf16_t*)(ws + OFF_MRG)};
                pg8::gemm_phase<pg8::EpiOF, pg8::SchedO>(ldsl, g, sq, E);
            } else if (PHS(5) && k == 5) {
                pg8::Gemm g{(const bf16_t*)(ws + OFF_MRG), nullptr, (const bf16_t*)(wl + WL_OUT), nullptr, 2048}; pg8::StaticOrder so; so.init(S, 2048, G, c);
                pg8::EpiResF E{xin, a.out};
                pg8::gemm_phase<pg8::EpiResF, pg8::StaticOrder>(ldsl, g, so, E);
            } else if (PHS(6) && k == 6) norm_phase<false>(a.out, a.in[I_NMLP] + (size_t)l * DM, (bf16_t*)(ws + OFF_U), nullptr);
            else if (PHS(7) && k == 7) {
                pg8::Gemm g{(const bf16_t*)(ws + OFF_U), nullptr, (const bf16_t*)(wl + WL_FF1), nullptr, 2048}; pg8::StaticOrder so; so.init(S, DFF, G, c);
                pg8::EpiFF1F E{(bf16_t*)(ws + OFF_H)};
                pg8::gemm_phase<pg8::EpiFF1F, pg8::StaticOrder>(ldsl, g, so, E);
            } else if (PHS(8)) {
                pg8::Gemm g{(const bf16_t*)(ws + OFF_H), nullptr, (const bf16_t*)(wl + WL_FF2), nullptr, DFF}; pg8::StaticOrder so; so.init(S, 2048, G, c);
                pg8::EpiResF E{a.out, a.out};
                pg8::gemm_phase<pg8::EpiResF, pg8::StaticOrder>(ldsl, g, so, E);
            }
        }
#ifdef EXTRA_SYNC
        GRID_BAR();
#endif
        if (ph + 1 < a.ph_hi) GRID_BAR();
    }
    if (PHS(101) && a.ph_hi == NPH) norm_phase<true>(a.out, a.in[I_NFIN], nullptr, a.out);
}
#ifndef MODE
#define MODE 1
#endif
#ifndef FASTMASK
#define FASTMASK 0x1ff
#endif
#ifndef FASTPRO
#define FASTPRO 1
#endif
extern "C" void kernel_launch(void* const* d_in, const int* in_sizes, int n_in, void* d_out, int out_size, void* d_ws, size_t ws_size, hipStream_t stream) {
    static int grid = 0;
    if (grid == 0) {
        if (n_in != 15 || out_size != S * DM || ws_size < WS_END) { fprintf(stderr, "kernel_launch: bad shapes n_in %d out %d ws %zu (need %zu)\n", n_in, out_size, ws_size, (size_t)WS_END); grid = -1; return; }
        if (hipFuncSetAttribute((const void*)mega, hipFuncAttributeMaxDynamicSharedMemorySize, LDS_BYTES) != hipSuccess) { fprintf(stderr, "kernel_launch: hipFuncSetAttribute failed\n"); grid = -1; return; }
        int dev = 0, cus = 0, per_cu = 0;
        hipGetDevice(&dev); hipDeviceGetAttribute(&cus, hipDeviceAttributeMultiprocessorCount, dev);
        hipOccupancyMaxActiveBlocksPerMultiprocessor(&per_cu, (const void*)mega, 512, LDS_BYTES);
        if (per_cu < 1) { fprintf(stderr, "kernel_launch: occupancy query says %d blocks/CU\n", per_cu); per_cu = 1; }
        (void)hipGetLastError();
        grid = cus;
        fprintf(stderr, "kernel_launch: cus %d per_cu %d grid %d\n", cus, per_cu, grid);
    }
    if (grid < 0) return;
    Args a{}; fill_args(a, d_in, d_out, d_ws);
    if (hipMemsetAsync((char*)d_ws + OFF_BAR, 0, 16384, stream) != hipSuccess) { fprintf(stderr, "kernel_launch: memset failed\n"); return; }
#if MODE == 1
    a.ph_lo = 0; a.ph_hi = NPH;
    void* args[] = {&a};
    hipError_t e = hipLaunchCooperativeKernel((const void*)mega, dim3(grid), dim3(512), args, LDS_BYTES, stream);
    if (e != hipSuccess) fprintf(stderr, "cooperative launch failed: %s (grid %d)\n", hipGetErrorString(e), grid);
#else
    const Bufs b = get_bufs(a.ws);
    naive_prologue(a, b, stream);
    if (FASTPRO) { a.ph_lo = 0; a.ph_hi = 1; hipLaunchKernelGGL(mega, dim3(grid), dim3(512), LDS_BYTES, stream, a); }
    for (int l = 0; l < DEPTH; ++l) for (int k = 0; k < 9; ++k) {
        if ((FASTMASK >> k) & 1) { a.ph_lo = 1 + 9 * l + k; a.ph_hi = a.ph_lo + 1; hipLaunchKernelGGL(mega, dim3(grid), dim3(512), LDS_BYTES, stream, a); }
        else naive_stage(l, k, a, b, stream);
    }
    naive_final(a, stream);
#endif
}
```

```cpp
#include <hip/hip_runtime.h>
#include <hip/hip_cooperative_groups.h>
#include <cstdio>
#include <cstdint>
#include <cmath>
namespace cg = cooperative_groups;

constexpr int S = 8192, DM = 2048, DEPTH = 4, NH = 8, DQK = 192, DFF = 8192, INT = 8256;
constexpr float EPS = 1e-6f;
typedef unsigned short bf16_t;
typedef _Float16 f16_t;

constexpr size_t MiB = 1u << 20;
constexpr size_t OFF_CS = 0;
constexpr size_t OFF_SSQ = 2 * MiB;
constexpr size_t OFF_KPER = 3 * MiB;
constexpr size_t OFF_QPER = 5 * MiB;
constexpr size_t OFF_U = 24 * MiB;
constexpr size_t OFF_CQ = 56 * MiB;
constexpr size_t OFF_CKV = 64 * MiB;
constexpr size_t OFF_QNA = 72 * MiB, OFF_KNA = 88 * MiB, OFF_VNA = 104 * MiB;
constexpr size_t OFF_GA = 120 * MiB, OFF_GB = 152 * MiB;
constexpr size_t OFF_QM = 184 * MiB, OFF_KM = 208 * MiB;
constexpr size_t OFF_VM = 232 * MiB;
constexpr size_t OFF_ATA = 248 * MiB, OFF_ATB = 264 * MiB;
constexpr size_t OFF_T = 280 * MiB;
constexpr size_t OFF_MRG = 344 * MiB;
constexpr size_t OFF_H = 376 * MiB;
constexpr size_t OFF_W = 504 * MiB;
constexpr size_t WL_IN = 0, WL_UQ = 33 * MiB, WL_UKV = WL_UQ + 3 * MiB / 2, WL_OA = WL_UKV + 2 * MiB, WL_OB = WL_OA + 4 * MiB,
                 WL_OUT = WL_OB + 4 * MiB, WL_FF1 = WL_OUT + 8 * MiB, WL_FF2 = WL_FF1 + 32 * MiB, WL_STRIDE = 117 * MiB;
constexpr size_t WS_END = OFF_W + 4 * WL_STRIDE;
constexpr int NIN_PAD = 8448;

__device__ __forceinline__ float bf2f(bf16_t v) { return __uint_as_float((unsigned)v << 16); }
__device__ __forceinline__ bf16_t f2bf(float f) { unsigned u = __float_as_uint(f); return (bf16_t)((u + 0x7fffu + ((u >> 16) & 1u)) >> 16); }
__device__ __forceinline__ unsigned pk2(float lo, float hi) { return (unsigned)f2bf(lo) | ((unsigned)f2bf(hi) << 16); }
__device__ __forceinline__ float sigmoidf(float v) { return __builtin_amdgcn_rcpf(1.0f + __expf(-v)); }

struct Args {
    const float* in[15];
    float* out;
    unsigned char* ws;
    int ph_lo, ph_hi;
};
__device__ __forceinline__ float inv_freq(int i) { double p = 1.0; for (int k = 0; k < i; ++k) p *= 0.7498942093324559; return (float)p; }
enum { I_X = 0, I_NMIX, I_WIN, I_NQA, I_WUQ, I_NKVA, I_WUKV, I_RPB, I_WOA, I_WOB, I_WOUT, I_NMLP, I_WFF1, I_WFF2, I_NFIN };

__device__ __forceinline__ void sincos_acc(float a, float& c, float& s) {
    const double x = (double)a;
    const double k = rint(x * 0.15915494309189535);
    double r = fma(-k, 6.283185307179586, x); r = fma(-k, 2.4492935982947064e-16, r);
    const double q = rint(r * 0.6366197723675814);
    double t = fma(-q, 1.5707963267948966, r); t = fma(-q, 6.123233995736766e-17, t);
    const int qi = ((int)q) & 3;
    const double t2 = t * t;
    const double sp = t * (1.0 + t2 * (-1.0 / 6 + t2 * (1.0 / 120 + t2 * (-1.0 / 5040 + t2 * (1.0 / 362880 + t2 * (-1.0 / 39916800 + t2 * (1.0 / 6227020800.0)))))));
    const double cp = 1.0 + t2 * (-0.5 + t2 * (1.0 / 24 + t2 * (-1.0 / 720 + t2 * (1.0 / 40320 + t2 * (-1.0 / 3628800 + t2 * (1.0 / 479001600 + t2 * (-1.0 / 87178291200.0)))))));
    double ss, cc;
    if (qi == 0) { ss = sp; cc = cp; } else if (qi == 1) { ss = cp; cc = -sp; } else if (qi == 2) { ss = -sp; cc = -cp; } else { ss = -cp; cc = sp; }
    c = (float)cc; s = (float)ss;
}
namespace nv {
__global__ __launch_bounds__(256) void k_cs(float2* CS, Args a) {
    const int idx = blockIdx.x * 256 + threadIdx.x;
    if (idx >= S * 32) return;
    const int pos = idx >> 5, i = idx & 31;
    const float ang = (float)pos * inv_freq(i);
    float c, s; sincos_acc(ang, c, s);
    CS[idx] = make_float2(c, s);
}
template <bool F32OUT>
__global__ __launch_bounds__(256) void k_norm(const float* X, const float* g, bf16_t* Ub, float* Of) {
    const int row = (blockIdx.x * 256 + threadIdx.x) >> 6, lane = threadIdx.x & 63;
    if (row >= S) return;
    const float4* xr = (const float4*)(X + (size_t)row * DM);
    float4 v[8]; float ss = 0.f;
#pragma unroll
    for (int j = 0; j < 8; ++j) { v[j] = xr[lane + 64 * j]; ss += v[j].x * v[j].x + v[j].y * v[j].y + v[j].z * v[j].z + v[j].w * v[j].w; }
#pragma unroll
    for (int o = 1; o < 64; o <<= 1) ss += __shfl_xor(ss, o);
    const float rinv = rsqrtf(ss * (1.0f / DM) + EPS);
    const float4* gr = (const float4*)g;
#pragma unroll
    for (int j = 0; j < 8; ++j) {
        const float4 gg = gr[lane + 64 * j];
        const float o0 = v[j].x * rinv * gg.x, o1 = v[j].y * rinv * gg.y, o2 = v[j].z * rinv * gg.z, o3 = v[j].w * rinv * gg.w;
        if (F32OUT) ((float4*)(Of + (size_t)row * DM))[lane + 64 * j] = make_float4(o0, o1, o2, o3);
        else ((uint2*)(Ub + (size_t)row * DM))[lane + 64 * j] = make_uint2(pk2(o0, o1), pk2(o2, o3));
    }
}
__global__ __launch_bounds__(256) void k_ssq(const bf16_t* CQ, const bf16_t* CKV, float* SSQ) {
    const int row = (blockIdx.x * 256 + threadIdx.x) >> 6, lane = threadIdx.x & 63;
    if (row >= S) return;
    float a = 0.f, b = 0.f;
    for (int j = lane; j < 512; j += 64) { const float x = bf2f(CQ[(size_t)row * 512 + j]), y = bf2f(CKV[(size_t)row * 512 + j]); a += x * x; b += y * y; }
#pragma unroll
    for (int o = 1; o < 64; o <<= 1) { a += __shfl_xor(a, o); b += __shfl_xor(b, o); }
    if (lane < 16) SSQ[(size_t)row * 16 + lane] = (lane == 0) ? a : (lane == 8 ? b : 0.f);
}
__device__ __forceinline__ float rinv_from_ssq(const float* SSQ, int row, int off) {
    const float4 a = *(const float4*)(SSQ + (size_t)row * 16 + off), b = *(const float4*)(SSQ + (size_t)row * 16 + off + 4);
    const float s = ((a.x + a.y) + (a.z + a.w)) + ((b.x + b.y) + (b.z + b.w));
    return rsqrtf(s * (1.0f / 512.0f) + EPS);
}
struct EpiIn { bf16_t *CQ, *CKV, *QNA, *KNA, *VNA; f16_t *GA, *GB; float* KPER;
    __device__ __forceinline__ void operator()(int row, int col, float v) const {
        if (col < 512) CQ[(size_t)row * 512 + col] = f2bf(v);
        else if (col < 1024) CKV[(size_t)row * 512 + col - 512] = f2bf(v);
        else if (col < 1088) KPER[(size_t)row * 64 + col - 1024] = v;
        else if (col < 2112) QNA[(size_t)row * 1024 + col - 1088] = f2bf(v);
        else if (col < 3136) KNA[(size_t)row * 1024 + col - 2112] = f2bf(v);
        else if (col < 4160) VNA[(size_t)row * 1024 + col - 3136] = f2bf(v);
        else if (col < 6208) GA[(size_t)row * 2048 + col - 4160] = (f16_t)sigmoidf(v);
        else GB[(size_t)row * 2048 + col - 6208] = (f16_t)sigmoidf(v);
    } };
struct EpiQ { bf16_t* QM; float* QPER; const float* SSQ;
    __device__ __forceinline__ void operator()(int row, int col, float v) const {
        v *= rinv_from_ssq(SSQ, row, 0); const int h = col / 192, j = col % 192;
        if (j < 128) QM[(size_t)row * 1536 + col] = f2bf(v); else QPER[(size_t)row * 512 + h * 64 + j - 128] = v;
    } };
struct EpiKV { bf16_t *KM, *VM; const float* SSQ;
    __device__ __forceinline__ void operator()(int row, int col, float v) const {
        v *= rinv_from_ssq(SSQ, row, 8); const int h = col / 256, j = col % 256;
        if (j < 128) KM[(size_t)row * 1536 + h * 192 + j] = f2bf(v); else VM[(size_t)row * 1024 + h * 128 + j - 128] = f2bf(v);
    } };
struct EpiOA { float* T; const f16_t* GA;
    __device__ __forceinline__ void operator()(int row, int col, float v) const { const size_t i = (size_t)row * 2048 + col; T[i] = (float)GA[i] * v; } };
struct EpiOB { const float* T; const f16_t* GB; bf16_t* MRG;
    __device__ __forceinline__ void operator()(int row, int col, float v) const { const size_t i = (size_t)row * 2048 + col; MRG[i] = f2bf(T[i] + (float)GB[i] * v); } };
struct EpiRes { const float* XI; float* XO;
    __device__ __forceinline__ void operator()(int row, int col, float v) const { const size_t i = (size_t)row * 2048 + col; XO[i] = XI[i] + v; } };
struct EpiFF1 { bf16_t* H;
    __device__ __forceinline__ void operator()(int row, int col, float v) const { const float r = v > 0.f ? v : 0.f; H[(size_t)row * DFF + col] = f2bf(r * r); } };

template <class Epi>
__global__ __launch_bounds__(256) void k_gemm(const bf16_t* A, int lda, const float* W, int ldw, const float* gain, int N, int K, Epi E) {
    __shared__ float As[16][132]; __shared__ float Bs[16][132];
    const int t = threadIdx.x, bm = blockIdx.y * 128, bn = blockIdx.x * 128, ty = t >> 4, tx = t & 15;
    float acc[8][8];
#pragma unroll
    for (int i = 0; i < 8; ++i)
#pragma unroll
        for (int j = 0; j < 8; ++j) acc[i][j] = 0.f;
    for (int k0 = 0; k0 < K; k0 += 16) {
        { const int r = t >> 1, kk = (t & 1) * 8; const uint4 v = *(const uint4*)(A + (size_t)(bm + r) * lda + k0 + kk);
          const unsigned w[4] = {v.x, v.y, v.z, v.w};
#pragma unroll
          for (int i = 0; i < 4; ++i) { float lo = __uint_as_float(w[i] << 16), hi = __uint_as_float(w[i] & 0xffff0000u);
              if (gain) { lo *= gain[k0 + kk + 2 * i]; hi *= gain[k0 + kk + 2 * i + 1]; }
              As[kk + 2 * i][r] = lo; As[kk + 2 * i + 1][r] = hi; } }
#pragma unroll
        for (int i = 0; i < 2; ++i) { const int k = (t >> 5) + 8 * i, n = (t & 31) * 4;
            float4 v = make_float4(0.f, 0.f, 0.f, 0.f); if (bn + n < N) v = *(const float4*)(W + (size_t)(k0 + k) * ldw + bn + n);
            *(float4*)&Bs[k][n] = v; }
        __syncthreads();
#pragma unroll
        for (int kk = 0; kk < 16; ++kk) {
            float a[8], b[8];
            const float4 a0 = *(const float4*)&As[kk][ty * 8], a1 = *(const float4*)&As[kk][ty * 8 + 4];
            const float4 b0 = *(const float4*)&Bs[kk][tx * 8], b1 = *(const float4*)&Bs[kk][tx * 8 + 4];
            a[0] = a0.x; a[1] = a0.y; a[2] = a0.z; a[3] = a0.w; a[4] = a1.x; a[5] = a1.y; a[6] = a1.z; a[7] = a1.w;
            b[0] = b0.x; b[1] = b0.y; b[2] = b0.z; b[3] = b0.w; b[4] = b1.x; b[5] = b1.y; b[6] = b1.z; b[7] = b1.w;
#pragma unroll
            for (int i = 0; i < 8; ++i)
#pragma unroll
                for (int j = 0; j < 8; ++j) acc[i][j] = fmaf(a[i], b[j], acc[i][j]);
        }
        __syncthreads();
    }
#pragma unroll
    for (int i = 0; i < 8; ++i)
#pragma unroll
        for (int j = 0; j < 8; ++j) { const int row = bm + ty * 8 + i, col = bn + tx * 8 + j; if (col < N) E(row, col, acc[i][j]); }
}
template <bool DOK, bool DOQ>
__global__ __launch_bounds__(256) void k_rope(const float2* CS, const float* KPER, const float* QPER, bf16_t* KM, bf16_t* QM) {
    const int idx = blockIdx.x * 256 + threadIdx.x; if (idx >= S * 32) return;
    const int row = idx >> 5, i = idx & 31; const float2 cs = CS[idx];
    if (DOK) { const float x1 = KPER[(size_t)row * 64 + i], x2 = KPER[(size_t)row * 64 + 32 + i];
      const bf16_t o1 = f2bf(x1 * cs.x - x2 * cs.y), o2 = f2bf(x2 * cs.x + x1 * cs.y);
      for (int h = 0; h < 8; ++h) { KM[(size_t)row * 1536 + h * 192 + 128 + i] = o1; KM[(size_t)row * 1536 + h * 192 + 160 + i] = o2; } }
    if (DOQ) for (int h = 0; h < 8; ++h) { const float x1 = QPER[(size_t)row * 512 + h * 64 + i], x2 = QPER[(size_t)row * 512 + h * 64 + 32 + i];
        QM[(size_t)row * 1536 + h * 192 + 128 + i] = f2bf(x1 * cs.x - x2 * cs.y); QM[(size_t)row * 1536 + h * 192 + 160 + i] = f2bf(x2 * cs.x + x1 * cs.y); }
}
template <bool NA>
__global__ __launch_bounds__(256) void k_attn(const bf16_t* Q, const bf16_t* Kb, const bf16_t* Vb, bf16_t* O, const float* rpb) {
    constexpr int DQ = NA ? 128 : 192, PER = DQ / 64, LDQ = NA ? 1024 : 1536;
    const int wave = (blockIdx.x * 256 + threadIdx.x) >> 6, lane = threadIdx.x & 63;
    const int q = wave >> 3, h = wave & 7;
    const float scale = NA ? 0.08838834764831845f : 0.07216878364870323f;
    float qv[PER];
#pragma unroll
    for (int i = 0; i < PER; ++i) qv[i] = bf2f(Q[(size_t)q * LDQ + h * DQ + lane * PER + i]);
    float m = -1e30f, l = 0.f, o0 = 0.f, o1 = 0.f;
    const int r = q >> 6, c = q & 63;
    const int rs = min(max(r - 4, 0), 120), cs = min(max(c - 8, 0), 48);
    const int nkeys = NA ? 128 : S;
    for (int kk = 0; kk < nkeys; ++kk) {
        int key = kk; float bias = 0.f;
        if (NA) { const int i = kk >> 4, kc = cs + (kk & 15), kr = rs + i; key = kr * 64 + kc;
            const int dy = kr - r + 7, dx = min(max(kc - c, -15), 15) + 15; bias = rpb[h * 465 + dy * 31 + dx]; }
        float s = 0.f;
#pragma unroll
        for (int i = 0; i < PER; ++i) s += qv[i] * bf2f(Kb[(size_t)key * LDQ + h * DQ + lane * PER + i]);
#pragma unroll
        for (int o = 1; o < 64; o <<= 1) s += __shfl_xor(s, o);
        s = s * scale + bias;
        const float mn = fmaxf(m, s), al = __expf(m - mn), p = __expf(s - mn);
        const unsigned vv = *(const unsigned*)(Vb + (size_t)key * 1024 + h * 128 + lane * 2);
        l = l * al + p; o0 = o0 * al + p * __uint_as_float(vv << 16); o1 = o1 * al + p * __uint_as_float(vv & 0xffff0000u); m = mn;
    }
    const float il = 1.0f / l;
    *(unsigned*)(O + (size_t)q * 1024 + h * 128 + lane * 2) = pk2(o0 * il, o1 * il);
}
}
static void fill_args(Args& a, void* const* d_in, void* d_out, void* d_ws) {
    for (int i = 0; i < 15; ++i) a.in[i] = (const float*)d_in[i];
    a.out = (float*)d_out; a.ws = (unsigned char*)d_ws;
    a.ph_lo = 0; a.ph_hi = 0;
}
struct Bufs { float2* CS; float *SSQ, *KPER, *QPER, *T; bf16_t *U, *CQ, *CKV, *QNA, *KNA, *VNA, *QM, *KM, *VM, *ATA, *ATB, *MRG, *H; f16_t *GA, *GB; };
static Bufs get_bufs(unsigned char* ws) {
    Bufs b; b.CS = (float2*)(ws + OFF_CS); b.SSQ = (float*)(ws + OFF_SSQ); b.KPER = (float*)(ws + OFF_KPER); b.QPER = (float*)(ws + OFF_QPER); b.T = (float*)(ws + OFF_T);
    b.U = (bf16_t*)(ws + OFF_U); b.CQ = (bf16_t*)(ws + OFF_CQ); b.CKV = (bf16_t*)(ws + OFF_CKV); b.QNA = (bf16_t*)(ws + OFF_QNA); b.KNA = (bf16_t*)(ws + OFF_KNA); b.VNA = (bf16_t*)(ws + OFF_VNA);
    b.QM = (bf16_t*)(ws + OFF_QM); b.KM = (bf16_t*)(ws + OFF_KM); b.VM = (bf16_t*)(ws + OFF_VM); b.ATA = (bf16_t*)(ws + OFF_ATA); b.ATB = (bf16_t*)(ws + OFF_ATB);
    b.MRG = (bf16_t*)(ws + OFF_MRG); b.H = (bf16_t*)(ws + OFF_H); b.GA = (f16_t*)(ws + OFF_GA); b.GB = (f16_t*)(ws + OFF_GB); return b;
}
static void naive_stage(int l, int k, const Args& a, const Bufs& b, hipStream_t st) {
    const float* x = a.in[I_X]; float* out = a.out; const float* xin = (l == 0) ? x : out;
    const float* w_in = a.in[I_WIN] + (size_t)l * DM * INT; const float* w_uq = a.in[I_WUQ] + (size_t)l * 512 * 1536; const float* w_ukv = a.in[I_WUKV] + (size_t)l * 512 * 2048;
    const float* w_oa = a.in[I_WOA] + (size_t)l * 1024 * 2048; const float* w_ob = a.in[I_WOB] + (size_t)l * 1024 * 2048; const float* w_out = a.in[I_WOUT] + (size_t)l * 2048 * 2048;
    const float* w_ff1 = a.in[I_WFF1] + (size_t)l * DM * DFF; const float* w_ff2 = a.in[I_WFF2] + (size_t)l * DFF * DM;
    const dim3 blk(256); const int rowgrid = S * 64 / 256;
    switch (k) {
    case 0: nv::k_norm<false><<<rowgrid, blk, 0, st>>>(xin, a.in[I_NMIX] + (size_t)l * DM, b.U, nullptr); break;
    case 1: { nv::EpiIn e{b.CQ, b.CKV, b.QNA, b.KNA, b.VNA, b.GA, b.GB, b.KPER};
        nv::k_gemm<nv::EpiIn><<<dim3(65, 64), blk, 0, st>>>(b.U, 2048, w_in, INT, nullptr, INT, 2048, e);
        nv::k_ssq<<<rowgrid, blk, 0, st>>>(b.CQ, b.CKV, b.SSQ);
        nv::k_rope<true, false><<<S * 32 / 256, blk, 0, st>>>(b.CS, b.KPER, b.QPER, b.KM, b.QM); break; }
    case 2: { nv::EpiQ eq{b.QM, b.QPER, b.SSQ}; nv::k_gemm<nv::EpiQ><<<dim3(12, 64), blk, 0, st>>>(b.CQ, 512, w_uq, 1536, a.in[I_NQA] + (size_t)l * 512, 1536, 512, eq);
        nv::EpiKV ek{b.KM, b.VM, b.SSQ}; nv::k_gemm<nv::EpiKV><<<dim3(16, 64), blk, 0, st>>>(b.CKV, 512, w_ukv, 2048, a.in[I_NKVA] + (size_t)l * 512, 2048, 512, ek);
        nv::k_rope<false, true><<<S * 32 / 256, blk, 0, st>>>(b.CS, b.KPER, b.QPER, b.KM, b.QM); break; }
    case 3: nv::k_attn<false><<<S * 8 * 64 / 256, blk, 0, st>>>(b.QM, b.KM, b.VM, b.ATA, nullptr);
        nv::k_attn<true><<<S * 8 * 64 / 256, blk, 0, st>>>(b.QNA, b.KNA, b.VNA, b.ATB, a.in[I_RPB] + (size_t)l * 8 * 465); break;
    case 4: { nv::EpiOA ea{b.T, b.GA}; nv::k_gemm<nv::EpiOA><<<dim3(16, 64), blk, 0, st>>>(b.ATA, 1024, w_oa, 2048, nullptr, 2048, 1024, ea);
        nv::EpiOB eb{b.T, b.GB, b.MRG}; nv::k_gemm<nv::EpiOB><<<dim3(16, 64), blk, 0, st>>>(b.ATB, 1024, w_ob, 2048, nullptr, 2048, 1024, eb); break; }
    case 5: { nv::EpiRes e{xin, out}; nv::k_gemm<nv::EpiRes><<<dim3(16, 64), blk, 0, st>>>(b.MRG, 2048, w_out, 2048, nullptr, 2048, 2048, e); break; }
    case 6: nv::k_norm<false><<<rowgrid, blk, 0, st>>>(out, a.in[I_NMLP] + (size_t)l * DM, b.U, nullptr); break;
    case 7: { nv::EpiFF1 e{b.H}; nv::k_gemm<nv::EpiFF1><<<dim3(64, 64), blk, 0, st>>>(b.U, 2048, w_ff1, DFF, nullptr, DFF, 2048, e); break; }
    case 8: { nv::EpiRes e{out, out}; nv::k_gemm<nv::EpiRes><<<dim3(16, 64), blk, 0, st>>>(b.H, DFF, w_ff2, 2048, nullptr, 2048, DFF, e); break; }
    }
}
static void naive_prologue(const Args& a, const Bufs& b, hipStream_t st) { nv::k_cs<<<S * 32 / 256, 256, 0, st>>>(b.CS, a); }
static void naive_final(const Args& a, hipStream_t st) { nv::k_norm<true><<<S * 64 / 256, 256, 0, st>>>(a.out, a.in[I_NFIN], nullptr, a.out); }
#define LAS __attribute__((address_space(3)))
typedef short bf16x8 __attribute__((ext_vector_type(8)));
typedef float f32x4 __attribute__((ext_vector_type(4)));
typedef unsigned u32x4 __attribute__((ext_vector_type(4)));
typedef _Float16 f16x2 __attribute__((ext_vector_type(2)));
__device__ __forceinline__ unsigned cvt_pk_bf16(float lo, float hi) { unsigned r; asm volatile("v_cvt_pk_bf16_f32 %0, %1, %2" : "=v"(r) : "v"(lo), "v"(hi)); return r; }
__device__ __forceinline__ unsigned cvt_pk_f16(float lo, float hi) { f16x2 h = {(_Float16)lo, (_Float16)hi}; return __builtin_bit_cast(unsigned, h); }
__device__ __forceinline__ float2 unpk_f16(unsigned w) { f16x2 h = __builtin_bit_cast(f16x2, w); return make_float2((float)h.x, (float)h.y); }
namespace pg8 {
constexpr int BM = 256, BK = 64, HALF = 128, HTB = HALF * BK * 2, STAGE_BYTES = 8 * HTB, NXCD = 8, WGM = 4;
__host__ __device__ __forceinline__ int lds_byte(int r, int c) { const int st = (r >> 4) * 2 + (c >> 5), rr = r & 15, cc = c & 31, ob = rr * 64 + cc * 2; return st * 1024 + (ob ^ (((ob >> 9) & 1) << 5)); }
__host__ __device__ __forceinline__ void stage_rc(int b, int& R, int& C) { const int st = b / 1024, sb = b % 1024, swz = sb ^ (((sb >> 9) & 1) << 5); R = (st >> 1) * 16 + swz / 64; C = (st & 1) * 32 + (swz % 64) / 2; }
__host__ __device__ __forceinline__ int perm32(int rho) { const int n = rho >> 4, i = rho & 15; return 8 * (i >> 2) + 4 * n + (i & 3); }
struct Unit { int pm, pn, z; };
struct Gemm { const bf16_t* A0; const bf16_t* A1; const bf16_t* B0; const bf16_t* B1; int K; };
struct StaticOrder {
    int nM, nN, nwg, G, c;
    __device__ void init(int M, int N, int G_, int c_) { nM = M / BM; nN = N / BM; nwg = nM * nN; G = G_; c = c_; }
    __device__ bool next(int i, Unit& u) const {
        const long L = (long)i * G + c; if (L >= nwg) return false;
        int wgid = (int)L; { const int q = nwg / NXCD, r = nwg % NXCD, xcd = wgid % NXCD, off = wgid / NXCD; wgid = (xcd < r ? xcd * (q + 1) : r * (q + 1) + (xcd - r) * q) + off; }
        const int nig = WGM * nN, gid = wgid / nig, fm = gid * WGM, gsz = (nM - fm) < WGM ? (nM - fm) : WGM;
        u.pm = fm + ((wgid % nig) % gsz); u.pn = (wgid % nig) / gsz; u.z = 0; return true;
    }
};
struct SchedQKV { StaticOrder so;
    __device__ void init(int G, int c) { so.init(S, 14 * 256, G, c); }
    __device__ bool next(int i, Unit& u) const { if (!so.next(i, u)) return false; if (u.pn >= 6) { u.pn -= 6; u.z = 1; } return true; } };
struct SchedO { StaticOrder so;
    __device__ void init(int G, int c) { so.init(S, 2048, G, c); }
    __device__ bool next(int i, Unit& u) const { if (!so.next(i >> 1, u)) return false; u.z = i & 1; return true; } };

template <class Epi, class Sched, bool ALIGN_EPI = true, bool SP2 = true>
__device__ __forceinline__ void gemm_phase(LAS unsigned char* lds, const Gemm g, const Sched& Sc, const Epi& E) {
    int tid_ = threadIdx.x; asm volatile("" : "+v"(tid_));
    const int tid = tid_, wid = __builtin_amdgcn_readfirstlane(tid >> 6), lane = tid & 63, wr = wid >> 2, wc = wid & 3, fr = lane & 15, fq = lane >> 4;
    const int K = g.K, nt = K / BK;
    unsigned voffA[2], voffB[2];
#pragma unroll
    for (int i = 0; i < 2; ++i) { int R, C; stage_rc(tid * 16 + i * 8192, R, C); const int Rb = Epi::PERM ? ((R & ~31) + perm32(R & 31)) : R;
        voffA[i] = (unsigned)(R * K + C) * 2u; voffB[i] = (unsigned)(Rb * K + C) * 2u; }
    const size_t kstep = (size_t)(BK * 2);
    const size_t hstep = (size_t)HALF * K * 2;
    const size_t tstep = 2 * hstep;
    const unsigned ldsw = (unsigned)wid * 1024u;
    const int aoff = lds_byte(wr * 64 + fr, fq * 8), boff = lds_byte(wc * 32 + fr, fq * 8);
#define PG8_SA(b, h) (((b) * 2 + (h)) * HTB)
#define PG8_SB(b, h) ((4 + (b) * 2 + (h)) * HTB)
#define PG8_STAGE(bufoff, gbase, voff) do { _Pragma("unroll") for (int _i = 0; _i < 2; ++_i) \
        __builtin_amdgcn_global_load_lds((const unsigned*)((const char*)(gbase) + (voff)[_i]), (LAS unsigned*)(lds + (bufoff) + ldsw + _i * 8192), 16, 0, 0); } while (0)
#define PG8_LDA(dst, b, h) do { _Pragma("unroll") for (int m = 0; m < 4; ++m) _Pragma("unroll") for (int k = 0; k < 2; ++k) dst[m][k] = *(const LAS bf16x8*)(lds + PG8_SA(b, h) + aoff + m * 2048 + k * 1024); } while (0)
#define PG8_LDB(dst, b, h) do { _Pragma("unroll") for (int n = 0; n < 2; ++n) _Pragma("unroll") for (int k = 0; k < 2; ++k) dst[n][k] = *(const LAS bf16x8*)(lds + PG8_SB(b, h) + boff + n * 2048 + k * 1024); } while (0)
#define PG8_MMA(ai, bj, At, Bt) do { __builtin_amdgcn_s_setprio(1); _Pragma("unroll") for (int m = 0; m < 4; ++m) _Pragma("unroll") for (int n = 0; n < 2; ++n) _Pragma("unroll") for (int k = 0; k < 2; ++k) \
        acc[ai][bj][m][n] = __builtin_amdgcn_mfma_f32_16x16x32_bf16(Bt[n][k], At[m][k], acc[ai][bj][m][n], 0, 0, 0); __builtin_amdgcn_s_setprio(0); } while (0)
#define PG8_WAIT_V(n) asm volatile("s_waitcnt vmcnt(" #n ")" ::: "memory")
#define PG8_WAIT_L(n) asm volatile("s_waitcnt lgkmcnt(" #n ")" ::: "memory")
#define PG8_BAR __builtin_amdgcn_s_barrier()
#define PG8_SCHED __builtin_amdgcn_sched_barrier(0)
#define PG8_APTR(u) ((const char*)((u).z ? g.A1 : g.A0) + (size_t)(u).pm * tstep)
#define PG8_BPTR(u) ((const char*)((u).z ? g.B1 : g.B0) + (size_t)(u).pn * tstep)
    Unit cur, nxt; int ui = 0;
    if (!Sc.next(0, cur)) return;
    f32x4 acc[2][2][4][2];
#pragma unroll
    for (int a = 0; a < 2; ++a)
#pragma unroll
        for (int b = 0; b < 2; ++b)
#pragma unroll
            for (int m = 0; m < 4; ++m)
#pragma unroll
                for (int n = 0; n < 2; ++n) acc[a][b][m][n] = (f32x4){0.f, 0.f, 0.f, 0.f};
    bf16x8 At[4][2], B0[2][2], B1[2][2];
    const char* cA = PG8_APTR(cur); const char* cB = PG8_BPTR(cur);
    if constexpr (SP2) {
        PG8_STAGE(PG8_SB(0, 0), cB, voffB); PG8_STAGE(PG8_SB(0, 1), cB + hstep, voffB); PG8_STAGE(PG8_SA(0, 0), cA, voffA); PG8_STAGE(PG8_SA(0, 1), cA + hstep, voffA);
        if (wr == 1) PG8_BAR;
        PG8_WAIT_V(2); PG8_BAR;
        PG8_STAGE(PG8_SB(1, 0), cB + kstep, voffB); PG8_STAGE(PG8_SA(1, 0), cA + kstep, voffA); PG8_STAGE(PG8_SB(1, 1), cB + hstep + kstep, voffB);
        PG8_WAIT_V(6); PG8_BAR;
    } else {
        PG8_STAGE(PG8_SB(0, 0), cB, voffB); PG8_STAGE(PG8_SA(0, 0), cA, voffA); PG8_STAGE(PG8_SB(0, 1), cB + hstep, voffB); PG8_STAGE(PG8_SA(0, 1), cA + hstep, voffA);
        if (wr == 1) PG8_BAR;
        PG8_WAIT_V(4); PG8_BAR;
        PG8_STAGE(PG8_SB(1, 0), cB + kstep, voffB); PG8_STAGE(PG8_SA(1, 0), cA + kstep, voffA); PG8_STAGE(PG8_SB(1, 1), cB + hstep + kstep, voffB);
        PG8_WAIT_V(6); PG8_BAR;
    }
    for (;;) {
        const bool has_next = Sc.next(ui + 1, nxt);
        const char* nA = has_next ? PG8_APTR(nxt) : cA; const char* nB = has_next ? PG8_BPTR(nxt) : cB;
        for (int t = 0; t < nt; t += 2) {
            const bool last = (t == nt - 2);
            const char* a1 = cA + (size_t)(t + 1) * kstep;
            const char* a2 = last ? nA : cA + (size_t)(t + 2) * kstep; const char* b2 = last ? nB : cB + (size_t)(t + 2) * kstep;
            const char* a3 = a2 + kstep; const char* b3 = b2 + kstep;
            if constexpr (SP2) {
            PG8_LDB(B0, 0, 0); PG8_LDB(B1, 0, 1); PG8_SCHED; PG8_LDA(At, 0, 0); PG8_STAGE(PG8_SA(1, 1), a1 + hstep, voffA);
            PG8_WAIT_V(8); PG8_WAIT_L(0); PG8_BAR; PG8_MMA(0, 0, At, B0); PG8_MMA(0, 1, At, B1); PG8_BAR; PG8_SCHED;
            PG8_LDA(At, 0, 1); PG8_STAGE(PG8_SB(0, 0), b2, voffB); PG8_STAGE(PG8_SB(0, 1), b2 + hstep, voffB); PG8_STAGE(PG8_SA(0, 0), a2, voffA);
            PG8_WAIT_V(8); PG8_WAIT_L(0); PG8_BAR; PG8_MMA(1, 0, At, B0); PG8_MMA(1, 1, At, B1); PG8_BAR; PG8_SCHED;
            PG8_LDB(B0, 1, 0); PG8_LDB(B1, 1, 1); PG8_SCHED; PG8_LDA(At, 1, 0); PG8_STAGE(PG8_SA(0, 1), a2 + hstep, voffA);
            PG8_WAIT_V(8); PG8_WAIT_L(0); PG8_BAR; PG8_MMA(0, 0, At, B0); PG8_MMA(0, 1, At, B1); PG8_BAR; PG8_SCHED;
            PG8_LDA(At, 1, 1); PG8_STAGE(PG8_SB(1, 0), b3, voffB); PG8_STAGE(PG8_SB(1, 1), b3 + hstep, voffB); PG8_STAGE(PG8_SA(1, 0), a3, voffA);
            PG8_WAIT_V(8); PG8_WAIT_L(0); PG8_BAR; PG8_MMA(1, 0, At, B0); PG8_MMA(1, 1, At, B1); PG8_BAR; PG8_SCHED;
            } else {
            PG8_LDB(B0, 0, 0); PG8_SCHED; PG8_LDA(At, 0, 0); PG8_STAGE(PG8_SA(1, 1), a1 + hstep, voffA);
            PG8_WAIT_L(8); PG8_BAR; PG8_WAIT_L(0); PG8_MMA(0, 0, At, B0); PG8_BAR; PG8_SCHED;
            PG8_LDB(B1, 0, 1); PG8_STAGE(PG8_SB(0, 0), b2, voffB);
            PG8_BAR; PG8_WAIT_L(0); PG8_MMA(0, 1, At, B1); PG8_BAR;
            PG8_LDA(At, 0, 1); PG8_STAGE(PG8_SA(0, 0), a2, voffA);
            PG8_BAR; PG8_WAIT_L(0); PG8_MMA(1, 0, At, B0); PG8_BAR; PG8_SCHED;
            PG8_STAGE(PG8_SB(0, 1), b2 + hstep, voffB);
            PG8_WAIT_V(6); PG8_BAR; PG8_MMA(1, 1, At, B1); PG8_BAR;
            PG8_LDB(B0, 1, 0); PG8_SCHED; PG8_LDA(At, 1, 0); PG8_STAGE(PG8_SA(0, 1), a2 + hstep, voffA);
            PG8_WAIT_L(8); PG8_BAR; PG8_WAIT_L(0); PG8_MMA(0, 0, At, B0); PG8_BAR; PG8_SCHED;
            PG8_LDB(B1, 1, 1); PG8_STAGE(PG8_SB(1, 0), b3, voffB);
            PG8_BAR; PG8_WAIT_L(0); PG8_MMA(0, 1, At, B1); PG8_BAR;
            PG8_LDA(At, 1, 1); PG8_STAGE(PG8_SA(1, 0), a3, voffA);
            PG8_BAR; PG8_WAIT_L(0); PG8_MMA(1, 0, At, B0); PG8_BAR; PG8_SCHED;
            PG8_STAGE(PG8_SB(1, 1), b3 + hstep, voffB);
            PG8_WAIT_V(6); PG8_BAR; PG8_MMA(1, 1, At, B1); PG8_BAR;
            }
        }
        if constexpr (ALIGN_EPI) { if (wr == 0) PG8_BAR; }
        E(acc, cur, wr, wc, fr, fq);
        if (!has_next) break;
#pragma unroll
        for (int a = 0; a < 2; ++a)
#pragma unroll
            for (int b = 0; b < 2; ++b)
#pragma unroll
                for (int m = 0; m < 4; ++m)
#pragma unroll
                    for (int n = 0; n < 2; ++n) acc[a][b][m][n] = (f32x4){0.f, 0.f, 0.f, 0.f};
        cur = nxt; cA = nA; cB = nB; ++ui;
        if constexpr (ALIGN_EPI) { if (wr == 1) PG8_BAR; }
    }
    PG8_WAIT_V(0);
    if constexpr (!ALIGN_EPI) { if (wr == 0) PG8_BAR; }
    PG8_BAR;
#undef PG8_SA
#undef PG8_SB
#undef PG8_STAGE
#undef PG8_LDA
#undef PG8_LDB
#undef PG8_MMA
#undef PG8_WAIT_V
#undef PG8_WAIT_L
#undef PG8_BAR
#undef PG8_SCHED
#undef PG8_APTR
#undef PG8_BPTR
}

typedef const f32x4 (&AccRef)[2][2][4][2];
__device__ __forceinline__ u32x4 pack8_bf16(const f32x4 v0, const f32x4 v1) { u32x4 w; w.x = cvt_pk_bf16(v0[0], v0[1]); w.y = cvt_pk_bf16(v0[2], v0[3]); w.z = cvt_pk_bf16(v1[0], v1[1]); w.w = cvt_pk_bf16(v1[2], v1[3]); return w; }
__device__ __forceinline__ float rinv_ssq(const float* SSQ, int row, int off) {
    const f32x4 a = *(const f32x4*)(SSQ + (size_t)row * 16 + off), b = *(const f32x4*)(SSQ + (size_t)row * 16 + off + 4);
    const float s = ((a[0] + a[1]) + (a[2] + a[3])) + ((b[0] + b[1]) + (b[2] + b[3]));
    return rsqrtf(s * (1.0f / 512.0f) + EPS);
}
__device__ __forceinline__ void rope8(const float2* cs, const f32x4 a0, const f32x4 a1, const f32x4 b0, const f32x4 b1, float sc, u32x4& o1, u32x4& o2) {
    float r1[8], r2[8];
#pragma unroll
    for (int j = 0; j < 8; ++j) { const float2 c = cs[j]; const float x1 = (j < 4 ? a0[j & 3] : a1[j & 3]) * sc, x2 = (j < 4 ? b0[j & 3] : b1[j & 3]) * sc;
        r1[j] = x1 * c.x - x2 * c.y; r2[j] = x2 * c.x + x1 * c.y; }
    o1.x = cvt_pk_bf16(r1[0], r1[1]); o1.y = cvt_pk_bf16(r1[2], r1[3]); o1.z = cvt_pk_bf16(r1[4], r1[5]); o1.w = cvt_pk_bf16(r1[6], r1[7]);
    o2.x = cvt_pk_bf16(r2[0], r2[1]); o2.y = cvt_pk_bf16(r2[2], r2[3]); o2.z = cvt_pk_bf16(r2[4], r2[5]); o2.w = cvt_pk_bf16(r2[6], r2[7]);
}
struct EpiInF { static constexpr bool PERM = true;
    bf16_t *CQ, *CKV, *QNA, *KNA, *VNA, *KM; f16_t *GA, *GB; float *SSQ, *KPER; const float2* CS;
    __device__ __forceinline__ void operator()(AccRef acc, const Unit& u, int wr, int wc, int fr, int fq) const {
        const int pn = u.pn, row0 = u.pm * BM + wr * 64 + fr, cb = wc * 32 + 8 * fq;
        if (pn < 16) {
            bf16_t* base; int ld, c0;
            if (pn < 2) { base = CQ; ld = 512; c0 = pn * 256; } else if (pn < 4) { base = CKV; ld = 512; c0 = (pn - 2) * 256; }
            else if (pn < 8) { base = QNA; ld = 1024; c0 = (pn - 4) * 256; } else if (pn < 12) { base = KNA; ld = 1024; c0 = (pn - 8) * 256; } else { base = VNA; ld = 1024; c0 = (pn - 12) * 256; }
#pragma unroll
            for (int ai = 0; ai < 2; ++ai)
#pragma unroll
                for (int m = 0; m < 4; ++m) { const int row = row0 + ai * HALF + m * 16; float ss = 0.f;
#pragma unroll
                    for (int bj = 0; bj < 2; ++bj) { const f32x4 v0 = acc[ai][bj][m][0], v1 = acc[ai][bj][m][1];
                        *(u32x4*)(base + (size_t)row * ld + c0 + bj * HALF + cb) = pack8_bf16(v0, v1);
                        ss += (v0[0] * v0[0] + v0[1] * v0[1]) + (v0[2] * v0[2] + v0[3] * v0[3]) + (v1[0] * v1[0] + v1[1] * v1[1]) + (v1[2] * v1[2] + v1[3] * v1[3]); }
                    if (pn < 4) { ss += __shfl_xor(ss, 16); ss += __shfl_xor(ss, 32); if (fq == 0) SSQ[(size_t)row * 16 + pn * 4 + wc] = ss; } }
        } else if (pn < 32) {
            f16_t* base = pn < 24 ? GA : GB; const int c0 = (pn < 24 ? pn - 16 : pn - 24) * 256;
#pragma unroll
            for (int ai = 0; ai < 2; ++ai)
#pragma unroll
                for (int m = 0; m < 4; ++m) { const int row = row0 + ai * HALF + m * 16;
#pragma unroll
                    for (int bj = 0; bj < 2; ++bj) { const f32x4 v0 = acc[ai][bj][m][0], v1 = acc[ai][bj][m][1]; u32x4 w;
                        w.x = cvt_pk_f16(sigmoidf(v0[0]), sigmoidf(v0[1])); w.y = cvt_pk_f16(sigmoidf(v0[2]), sigmoidf(v0[3]));
                        w.z = cvt_pk_f16(sigmoidf(v1[0]), sigmoidf(v1[1])); w.w = cvt_pk_f16(sigmoidf(v1[2]), sigmoidf(v1[3]));
                        *(u32x4*)(base + (size_t)row * 2048 + c0 + bj * HALF + cb) = w; } }
        }
    } };
struct EpiQKVF { static constexpr bool PERM = true;
    bf16_t *QM, *KM, *VM; const float* SSQ; const float2* CS;
    __device__ __forceinline__ void operator()(AccRef acc, const Unit& u, int wr, int wc, int fr, int fq) const {
        const int pn = u.pn, z = u.z, row0 = u.pm * BM + wr * 64 + fr, cb = wc * 32 + 8 * fq;
#pragma unroll
        for (int ai = 0; ai < 2; ++ai)
#pragma unroll
            for (int m = 0; m < 4; ++m) { const int row = row0 + ai * HALF + m * 16; const float r = rinv_ssq(SSQ, row, z ? 8 : 0);
                if (z == 0 && pn >= 4) {
                    const int head = 4 * (pn - 4) + wc, i0 = 8 * fq; u32x4 o1, o2;
                    rope8(CS + (size_t)row * 32 + i0, acc[ai][0][m][0], acc[ai][0][m][1], acc[ai][1][m][0], acc[ai][1][m][1], r, o1, o2);
                    bf16_t* q = QM + (size_t)row * 1536 + head * 192 + 128 + i0; *(u32x4*)q = o1; *(u32x4*)(q + 32) = o2;
                } else {
#pragma unroll
                    for (int bj = 0; bj < 2; ++bj) { const f32x4 v0 = acc[ai][bj][m][0] * r, v1 = acc[ai][bj][m][1] * r; bf16_t* dst;
                        if (z == 0) dst = QM + (size_t)row * 1536 + (2 * pn + bj) * 192 + cb;
                        else if (pn < 4) dst = KM + (size_t)row * 1536 + (2 * pn + bj) * 192 + cb;
                        else dst = VM + (size_t)row * 1024 + (2 * (pn - 4) + bj) * 128 + cb;
                        *(u32x4*)dst = pack8_bf16(v0, v1); }
                } }
    } };
struct EpiOF { static constexpr bool PERM = true;
    float* T; const f16_t *GA, *GB; bf16_t* MRG;
    __device__ __forceinline__ void operator()(AccRef acc, const Unit& u, int wr, int wc, int fr, int fq) const {
        const int row0 = u.pm * BM + wr * 64 + fr, cb = u.pn * 256 + wc * 32 + 8 * fq;
#pragma unroll
        for (int ai = 0; ai < 2; ++ai)
#pragma unroll
            for (int m = 0; m < 4; ++m) { const int row = row0 + ai * HALF + m * 16;
#pragma unroll
                for (int bj = 0; bj < 2; ++bj) { const size_t idx = (size_t)row * 2048 + cb + bj * HALF;
                    const u32x4 gw = *(const u32x4*)((u.z ? GB : GA) + idx);
                    const float2 g0 = unpk_f16(gw.x), g1 = unpk_f16(gw.y), g2 = unpk_f16(gw.z), g3 = unpk_f16(gw.w);
                    f32x4 v0 = acc[ai][bj][m][0], v1 = acc[ai][bj][m][1];
                    v0[0] *= g0.x; v0[1] *= g0.y; v0[2] *= g1.x; v0[3] *= g1.y; v1[0] *= g2.x; v1[1] *= g2.y; v1[2] *= g3.x; v1[3] *= g3.y;
                    if (u.z == 0) { *(f32x4*)(T + idx) = v0; *(f32x4*)(T + idx + 4) = v1; }
                    else { v0 += *(const f32x4*)(T + idx); v1 += *(const f32x4*)(T + idx + 4); *(u32x4*)(MRG + idx) = pack8_bf16(v0, v1); } } }
    } };
struct EpiResF { static constexpr bool PERM = true;
    const float* XI; float* XO;
    __device__ __forceinline__ void operator()(AccRef acc, const Unit& u, int wr, int wc, int fr, int fq) const {
        const int row0 = u.pm * BM + wr * 64 + fr, cb = u.pn * 256 + wc * 32 + 8 * fq;
#pragma unroll
        for (int ai = 0; ai < 2; ++ai)
#pragma unroll
            for (int m = 0; m < 4; ++m) { const int row = row0 + ai * HALF + m * 16;
#pragma unroll
                for (int bj = 0; bj < 2; ++bj) { const size_t idx = (size_t)row * 2048 + cb + bj * HALF;
                    const f32x4 x0 = *(const f32x4*)(XI + idx), x1 = *(const f32x4*)(XI + idx + 4);
                    *(f32x4*)(XO + idx) = x0 + acc[ai][bj][m][0]; *(f32x4*)(XO + idx + 4) = x1 + acc[ai][bj][m][1]; } }
    } };
struct EpiFF1F { static constexpr bool PERM = true;
    bf16_t* H;
    __device__ __forceinline__ void operator()(AccRef acc, const Unit& u, int wr, int wc, int fr, int fq) const {
        const int row0 = u.pm * BM + wr * 64 + fr, cb = u.pn * 256 + wc * 32 + 8 * fq;
#pragma unroll
        for (int ai = 0; ai < 2; ++ai)
#pragma unroll
            for (int m = 0; m < 4; ++m) { const int row = row0 + ai * HALF + m * 16;
#pragma unroll
                for (int bj = 0; bj < 2; ++bj) { f32x4 v0 = acc[ai][bj][m][0], v1 = acc[ai][bj][m][1];
#pragma unroll
                    for (int j = 0; j < 4; ++j) { const float a = fmaxf(v0[j], 0.f), b = fmaxf(v1[j], 0.f); v0[j] = a * a; v1[j] = b * b; }
                    *(u32x4*)(H + (size_t)row * DFF + cb + bj * HALF) = pack8_bf16(v0, v1); } }
    } };
}
#ifndef ATT_PIPE
#define ATT_PIPE 0
#endif
namespace att {
typedef short s16x4 __attribute__((ext_vector_type(4)));
typedef float f32x16 __attribute__((ext_vector_type(16)));
constexpr int NW = 8, QBLK = 32, KVBLK = 64;
constexpr float THR = 8.f;
constexpr int SHM_V = KVBLK * 128 * 2;
#define SBAR() __builtin_amdgcn_sched_barrier(0)
#define KSWZ(row, colB, RB) ((row) * (RB) + ((colB) ^ (((row) & 7) << 4)))
__device__ __forceinline__ int crow(int r, int hi) { return (r & 3) + 8 * (r >> 2) + 4 * hi; }
template <int DQ> struct Cfg { static constexpr float SCALE = DQ == 192 ? 0.07216878364870323f : 0.08838834764831845f; static constexpr int RB = DQ * 2, SHM_K = KVBLK * DQ * 2; };

template <int DQ> __device__ __forceinline__ void partialSM(f32x16& p0, f32x16& p1, float& m_reg, float& mn, float& alpha) {
  constexpr float SCALE = Cfg<DQ>::SCALE, C = SCALE * 1.4426950408889634f;
  float pmax = p0[0];
#pragma unroll
  for (int r = 1; r < 16; ++r) pmax = fmaxf(pmax, p0[r]);
#pragma unroll
  for (int r = 0; r < 16; ++r) pmax = fmaxf(pmax, p1[r]);
  { auto rr = __builtin_amdgcn_permlane32_swap(__float_as_uint(pmax), __float_as_uint(pmax), false, false);
    pmax = fmaxf(__uint_as_float(rr[0]), __uint_as_float(rr[1])); }
  if (__builtin_expect(__all(pmax - m_reg <= THR / SCALE), 1)) { mn = m_reg; alpha = 1.f; }
  else { mn = fmaxf(m_reg, pmax); alpha = __builtin_amdgcn_exp2f((m_reg - mn) * C); m_reg = mn; }
  const float mnC = -mn * C;
#pragma unroll
  for (int r = 0; r < 16; ++r) p0[r] = fmaf(p0[r], C, mnC);
#pragma unroll
  for (int r = 0; r < 16; ++r) p1[r] = fmaf(p1[r], C, mnC);
#pragma unroll
  for (int r = 0; r < 16; ++r) p0[r] = __builtin_amdgcn_exp2f(p0[r]);
}
__device__ __forceinline__ void finishSM(f32x16& p0, f32x16& p1, float alpha, float& l_reg, bf16x8& pa0, bf16x8& pa1, bf16x8& pa2, bf16x8& pa3) {
#pragma unroll
  for (int r = 0; r < 16; ++r) p1[r] = __builtin_amdgcn_exp2f(p1[r]);
  float ps = 0;
#pragma unroll
  for (int r = 0; r < 16; ++r) ps += p0[r];
#pragma unroll
  for (int r = 0; r < 16; ++r) ps += p1[r];
  { auto rr = __builtin_amdgcn_permlane32_swap(__float_as_uint(ps), __float_as_uint(ps), false, false);
    ps = __uint_as_float(rr[0]) + __uint_as_float(rr[1]); }
  l_reg = l_reg * alpha + ps;
#define PK4(P, BASE, OUT) do { unsigned a0 = cvt_pk_bf16(P[BASE + 0], P[BASE + 1]), a1 = cvt_pk_bf16(P[BASE + 2], P[BASE + 3]);   \
    unsigned b0 = cvt_pk_bf16(P[BASE + 4], P[BASE + 5]), b1 = cvt_pk_bf16(P[BASE + 6], P[BASE + 7]);                              \
    auto r0 = __builtin_amdgcn_permlane32_swap(a0, b0, false, false); auto r1 = __builtin_amdgcn_permlane32_swap(a1, b1, false, false); \
    u32x4 w = {r0[0], r1[0], r0[1], r1[1]}; OUT = __builtin_bit_cast(bf16x8, w); } while (0)
  PK4(p0, 0, pa0); PK4(p0, 8, pa1); PK4(p1, 0, pa2); PK4(p1, 8, pa3);
#undef PK4
}
template <int DQ> __device__ __forceinline__ void qkt(f32x16& p0, f32x16& p1, const char* Ks, const bf16x8* qr, int r32, int hi) {
  constexpr int RB = Cfg<DQ>::RB;
  p0 = f32x16{}; p1 = f32x16{};
#pragma unroll
  for (int d0 = 0; d0 < DQ / 16; ++d0) { const int cb = (d0 * 16 + hi * 8) * 2;
    const bf16x8 b0 = *reinterpret_cast<const bf16x8*>(Ks + KSWZ(r32, cb, RB));
    const bf16x8 b1 = *reinterpret_cast<const bf16x8*>(Ks + KSWZ(32 + r32, cb, RB));
    p0 = __builtin_amdgcn_mfma_f32_32x32x16_bf16(b0, qr[d0], p0, 0, 0, 0);
    p1 = __builtin_amdgcn_mfma_f32_32x32x16_bf16(b1, qr[d0], p1, 0, 0, 0); }
}
__device__ __forceinline__ int v_st(int k, int c) { const int kk = (k & ~0xC) | ((k & 4) << 1) | ((k & 8) >> 1); return ((kk >> 3) * 4 + (c >> 5)) * 512 + ((kk & 7) * 32 + (c & 31)) * 2; }
__device__ __forceinline__ int v_rd_base(int lane) { return ((lane & 3) << 3) | (((lane >> 2) & 3) << 6) | (((lane >> 4) & 1) << 5) | (((lane >> 5) & 1) << 8); }
constexpr int v_rd_off(int d0, int ks, int half) { return d0 * 512 + ks * 4096 + half * 2048; }
template <int OFF> __device__ __forceinline__ s16x4 tr_read(int vb) {
  s16x4 r; asm volatile("ds_read_b64_tr_b16 %0, %1 offset:%2" : "=&v"(r) : "v"(vb), "i"(OFF) : "memory"); return r;
}
template <int D0> __device__ __forceinline__ void pv_one(f32x16& od, int vb, bf16x8 pa0, bf16x8 pa1, bf16x8 pa2, bf16x8 pa3) {
  const s16x4 l0 = tr_read<v_rd_off(D0, 0, 0)>(vb), h0 = tr_read<v_rd_off(D0, 0, 1)>(vb), l1 = tr_read<v_rd_off(D0, 1, 0)>(vb), h1 = tr_read<v_rd_off(D0, 1, 1)>(vb);
  const s16x4 l2 = tr_read<v_rd_off(D0, 2, 0)>(vb), h2 = tr_read<v_rd_off(D0, 2, 1)>(vb), l3 = tr_read<v_rd_off(D0, 3, 0)>(vb), h3 = tr_read<v_rd_off(D0, 3, 1)>(vb);
  asm volatile("s_waitcnt lgkmcnt(0)" ::: "memory"); SBAR();
#define PK(L, H) (bf16x8){L[0], L[1], L[2], L[3], H[0], H[1], H[2], H[3]}
  od = __builtin_amdgcn_mfma_f32_32x32x16_bf16(pa0, PK(l0, h0), od, 0, 0, 0);
  od = __builtin_amdgcn_mfma_f32_32x32x16_bf16(pa1, PK(l1, h1), od, 0, 0, 0);
  od = __builtin_amdgcn_mfma_f32_32x32x16_bf16(pa2, PK(l2, h2), od, 0, 0, 0);
  od = __builtin_amdgcn_mfma_f32_32x32x16_bf16(pa3, PK(l3, h3), od, 0, 0, 0);
#undef PK
}
__device__ __forceinline__ void pv_d0(f32x16* o, int vb, bf16x8 pa0, bf16x8 pa1, bf16x8 pa2, bf16x8 pa3) {
  pv_one<0>(o[0], vb, pa0, pa1, pa2, pa3); pv_one<1>(o[1], vb, pa0, pa1, pa2, pa3); pv_one<2>(o[2], vb, pa0, pa1, pa2, pa3); pv_one<3>(o[3], vb, pa0, pa1, pa2, pa3);
}
struct NaCtx { const float* btab; int r, qc, cstart, wstart; };
__device__ __forceinline__ void na_mask(f32x16& p0, f32x16& p1, const NaCtx& c, int kr, int hi) {
  const bool inwin = (kr >= c.wstart) && (kr < c.wstart + 8);
  const int dy = min(max(kr - c.r + 7, 0), 14);
#pragma unroll
  for (int r = 0; r < 16; ++r) {
    const int kc0 = crow(r, hi), kc1 = kc0 + 32;
    const bool v0 = inwin && ((unsigned)(kc0 - c.cstart) < 16u), v1 = inwin && ((unsigned)(kc1 - c.cstart) < 16u);
    const int i0 = dy * 31 + min(max(kc0 - c.qc, -15), 15) + 15, i1 = dy * 31 + min(max(kc1 - c.qc, -15), 15) + 15;
    p0[r] = v0 ? p0[r] + c.btab[i0] : -1e30f; p1[r] = v1 ? p1[r] + c.btab[i1] : -1e30f;
  }
}
template <int DQ, bool NA>
__device__ __forceinline__ void attn_unit(const bf16_t* __restrict__ Qb, int ldq, const bf16_t* __restrict__ Kh, int ldk, const bf16_t* __restrict__ Vh, int ldv,
                                          bf16_t* __restrict__ Ob, int ldo, int NT, char* lds, const NaCtx nc, int krow0) {
  constexpr int RB = Cfg<DQ>::RB, SHM_K = Cfg<DQ>::SHM_K, NKC = DQ / 64, CPR = DQ / 8;
  int tid_ = threadIdx.x; asm volatile("" : "+v"(tid_));
  const int tid = tid_, wid = tid >> 6, lane = tid & 63, r32 = lane & 31, hi = lane >> 5;
  char* V_lds = lds; char* K_lds = lds + 2 * SHM_V;
  float* ws = (float*)(lds + 2 * SHM_V + 2 * SHM_K) + wid * 64; float* li_l = ws; float* al_l = ws + 32;
  float m_reg = -1e30f, l_reg = 0; f32x16 o[4] = {}; bf16x8 qr[DQ / 16];
  const bf16_t* Qw = Qb + (long)(wid * QBLK + r32) * ldq + hi * 8;
#pragma unroll
  for (int d0 = 0; d0 < DQ / 16; ++d0) qr[d0] = *reinterpret_cast<const bf16x8*>(Qw + d0 * 16);
  const int sr = tid >> 4, sc = (tid & 15) * 8, vst0 = v_st(sr, sc), vst1 = v_st(32 + sr, sc);
  int krow[NKC], kcol[NKC];
#pragma unroll
  for (int i = 0; i < NKC; ++i) { const int c = tid + 512 * i; krow[i] = c / CPR; kcol[i] = (c % CPR) * 8; }
  const int vb0 = (int)(uintptr_t)V_lds + v_rd_base(lane);
  bf16x8 vs0, vs1, ks[NKC];
#define SLOAD(k0) do { vs0 = *reinterpret_cast<const bf16x8*>(&Vh[(long)((k0) + sr) * ldv + sc]); vs1 = *reinterpret_cast<const bf16x8*>(&Vh[(long)((k0) + 32 + sr) * ldv + sc]); \
    _Pragma("unroll") for (int i_ = 0; i_ < NKC; ++i_) ks[i_] = *reinterpret_cast<const bf16x8*>(&Kh[(long)((k0) + krow[i_]) * ldk + kcol[i_]]); } while (0)
#define SWRITE(b) do { *(bf16x8*)(V_lds + (b) * SHM_V + vst0) = vs0; *(bf16x8*)(V_lds + (b) * SHM_V + vst1) = vs1; \
    _Pragma("unroll") for (int i_ = 0; i_ < NKC; ++i_) *(bf16x8*)(K_lds + (b) * SHM_K + KSWZ(krow[i_], kcol[i_] * 2, RB)) = ks[i_]; } while (0)
#define SWAIT() asm volatile("s_waitcnt vmcnt(0)" ::: "memory")
#define RESC(a) do { if (__any((a) < 1.f)) { if (hi == 0) al_l[r32] = (a); asm volatile("s_waitcnt lgkmcnt(0)" ::: "memory"); \
    _Pragma("unroll") for (int d = 0; d < 4; ++d) _Pragma("unroll") for (int r = 0; r < 16; ++r) o[d][r] *= al_l[crow(r, hi)]; } } while (0)
#define MASK(P0, P1, t) do { if (NA) na_mask(P0, P1, nc, krow0 + (t), hi); } while (0)
#if ATT_PIPE
  f32x16 pA0, pA1, pB0, pB1; float mnA, mnB, alA, alB; bf16x8 pa0, pa1, pa2, pa3;
  SLOAD(0); SWAIT(); SWRITE(0); __syncthreads();
  qkt<DQ>(pA0, pA1, K_lds, qr, r32, hi); MASK(pA0, pA1, 0); partialSM<DQ>(pA0, pA1, m_reg, mnA, alA);
  SLOAD(KVBLK);
  SWAIT(); SWRITE(1); __syncthreads();
  for (int j = 1; j + 1 < NT; j += 2) {
    SBAR(); qkt<DQ>(pB0, pB1, K_lds + SHM_K, qr, r32, hi); MASK(pB0, pB1, j);
    finishSM(pA0, pA1, alA, l_reg, pa0, pa1, pa2, pa3); SBAR();
    SLOAD((j + 1) * KVBLK); SBAR();
    pv_d0(o, vb0, pa0, pa1, pa2, pa3); partialSM<DQ>(pB0, pB1, m_reg, mnB, alB);
    __syncthreads(); SWAIT(); SWRITE(0);
    RESC(alB); __syncthreads();
    SBAR(); qkt<DQ>(pA0, pA1, K_lds, qr, r32, hi); MASK(pA0, pA1, j + 1);
    finishSM(pB0, pB1, alB, l_reg, pa0, pa1, pa2, pa3); SBAR();
    SLOAD((j + 2) * KVBLK); SBAR();
    pv_d0(o, vb0 + SHM_V, pa0, pa1, pa2, pa3); partialSM<DQ>(pA0, pA1, m_reg, mnA, alA);
    __syncthreads(); SWAIT(); SWRITE(1);
    RESC(alA); __syncthreads();
  }
  SBAR(); qkt<DQ>(pB0, pB1, K_lds + SHM_K, qr, r32, hi); MASK(pB0, pB1, NT - 1);
  finishSM(pA0, pA1, alA, l_reg, pa0, pa1, pa2, pa3); SBAR();
  pv_d0(o, vb0, pa0, pa1, pa2, pa3); partialSM<DQ>(pB0, pB1, m_reg, mnB, alB);
  __syncthreads(); RESC(alB);
  finishSM(pB0, pB1, alB, l_reg, pa0, pa1, pa2, pa3); SBAR();
  pv_d0(o, vb0 + SHM_V, pa0, pa1, pa2, pa3);
#else
  f32x16 p0, p1; float mn, al; bf16x8 pa0, pa1, pa2, pa3;
  SLOAD(0); SWAIT(); SWRITE(0); __syncthreads();
  for (int j = 0; j < NT; ++j) {
    const int b = j & 1;
    if (j + 1 < NT) SLOAD((j + 1) * KVBLK);
    SBAR();
    bool act = true;
    if (NA) { const int kr = krow0 + j; act = (kr >= nc.wstart) && (kr < nc.wstart + 8); }
    if (act) {
    qkt<DQ>(p0, p1, K_lds + b * SHM_K, qr, r32, hi); MASK(p0, p1, j);
    partialSM<DQ>(p0, p1, m_reg, mn, al);
    RESC(al);
    finishSM(p0, p1, al, l_reg, pa0, pa1, pa2, pa3); SBAR();
    pv_d0(o, vb0 + b * SHM_V, pa0, pa1, pa2, pa3);
    }
    if (j + 1 < NT) { SWAIT(); SWRITE(b ^ 1); }
    __syncthreads();
  }
#endif
  if (hi == 0) li_l[r32] = l_reg; asm volatile("s_waitcnt lgkmcnt(0)" ::: "memory");
  float rli[16];
#pragma unroll
  for (int r = 0; r < 16; ++r) rli[r] = __builtin_amdgcn_rcpf(li_l[crow(r, hi)]);
  bf16_t* Ow = Ob + (long)(wid * QBLK) * ldo;
  { bf16_t* stg = (bf16_t*)(lds + wid * 8192);
#pragma unroll
    for (int r = 0; r < 16; ++r) { const int orow = crow(r, hi);
#pragma unroll
      for (int d0 = 0; d0 < 4; ++d0) stg[orow * 128 + d0 * 32 + r32] = f2bf(o[d0][r] * rli[r]); }
    asm volatile("s_waitcnt lgkmcnt(0)" ::: "memory");
#pragma unroll
    for (int i = 0; i < 8; ++i) { const int row = i * 4 + (lane >> 4), ch = lane & 15; const u32x4 v = *(const u32x4*)(stg + row * 128 + ch * 8); *(u32x4*)(Ow + (long)row * ldo + ch * 8) = v; } }
  __syncthreads();
#undef SLOAD
#undef SWRITE
#undef SWAIT
#undef RESC
#undef MASK
}
#undef SBAR
}
namespace att2 {
using att::f32x16; using att::s16x4; using att::crow; using att::partialSM; using att::finishSM; using att::pv_d0; using att::v_rd_base; using att::NaCtx; using att::na_mask;
constexpr int KVBLK = 64, QBLK = 32, SLOTV = 16384;
#define SBAR() __builtin_amdgcn_sched_barrier(0)
template <int OFF> __device__ __forceinline__ bf16x8 lds_rd128(int addr) { bf16x8 r; asm volatile("ds_read_b128 %0, %1 offset:%2" : "=v"(r) : "v"(addr), "i"(OFF)); return r; }
template <int DQ> __device__ __forceinline__ void qkt(f32x16& p0, f32x16& p1, LAS const unsigned char* Ks, const int (&kb)[4], const bf16x8* qr) {
  constexpr int N = DQ / 16;
  const int kbase = (int)(uintptr_t)Ks;
  int ka[4];
#pragma unroll
  for (int q = 0; q < 4; ++q) ka[q] = kb[q] + kbase;
  p0 = f32x16{}; p1 = f32x16{};
  bf16x8 f0[3], f1[3];
#define QK_RD(d) do { constexpr int off_ = ((d) >> 2) * 8192; f0[(d) % 3] = lds_rd128<off_>(ka[(d) & 3]); f1[(d) % 3] = lds_rd128<off_ + 4096>(ka[(d) & 3]); } while (0)
  QK_RD(0); QK_RD(1); QK_RD(2);
  __builtin_amdgcn_s_setprio(1);
#define QK_STEP(d) do { \
    if ((d) + 2 < N) asm volatile("s_waitcnt lgkmcnt(4)" : "+v"(f0[(d) % 3]), "+v"(f1[(d) % 3])); \
    else if ((d) + 1 < N) asm volatile("s_waitcnt lgkmcnt(2)" : "+v"(f0[(d) % 3]), "+v"(f1[(d) % 3])); \
    else asm volatile("s_waitcnt lgkmcnt(0)" : "+v"(f0[(d) % 3]), "+v"(f1[(d) % 3])); \
    p0 = __builtin_amdgcn_mfma_f32_32x32x16_bf16(f0[(d) % 3], qr[d], p0, 0, 0, 0); \
    p1 = __builtin_amdgcn_mfma_f32_32x32x16_bf16(f1[(d) % 3], qr[d], p1, 0, 0, 0); \
    if ((d) + 3 < N) { QK_RD((d) + 3); } } while (0)
  QK_STEP(0); QK_STEP(1); QK_STEP(2); QK_STEP(3); QK_STEP(4); QK_STEP(5); QK_STEP(6); QK_STEP(7);
  if constexpr (N > 8) { QK_STEP(8); QK_STEP(9); QK_STEP(10); QK_STEP(11); }
#undef QK_STEP
#undef QK_RD
  __builtin_amdgcn_s_setprio(0);
}
template <int DQ> struct L { static constexpr int SLOTK = KVBLK * DQ * 2, VBASE = 4 * SLOTK, WSOFF = VBASE + 3 * SLOTV, BYTES = WSOFF + 2048; };
template <int DQ, bool NA>
__device__ __forceinline__ void attn_unit(const bf16_t* __restrict__ Qb, int ldq, const bf16_t* __restrict__ Kh, int ldk, const bf16_t* __restrict__ Vh, int ldv,
                                          bf16_t* __restrict__ Ob, int ldo, int NT, LAS unsigned char* lds, const NaCtx nc, int krow0) {
  constexpr int SLOTK = L<DQ>::SLOTK, VBASE = L<DQ>::VBASE, NKC = DQ / 64;
  int tid_ = threadIdx.x; asm volatile("" : "+v"(tid_));
  const int tid = tid_, wid = __builtin_amdgcn_readfirstlane(tid >> 6), lane = tid & 63, r32 = lane & 31, hi = lane >> 5;
  LAS float* ws = (LAS float*)(lds + L<DQ>::WSOFF) + wid * 64; LAS float* li_l = ws; LAS float* al_l = ws + 32;
  float m_reg = -1e30f, l_reg = 0; f32x16 o[4] = {}; bf16x8 qr[DQ / 16];
  const bf16_t* Qw = Qb + (long)(wid * QBLK + r32) * ldq + hi * 8;
#pragma unroll
  for (int d0 = 0; d0 < DQ / 16; ++d0) qr[d0] = *reinterpret_cast<const bf16x8*>(Qw + d0 * 16);
  const int krow = 8 * wid + (lane >> 3), kch = (lane & 7) ^ ((krow >> 1) & 7);
  const bf16_t* kg0 = Kh + (long)krow * ldk + kch * 8;
  const int vkk = (wid >> 1) * 8 + ((lane & 31) >> 2), vkey = (vkk & ~0xC) | ((vkk & 4) << 1) | ((vkk & 8) >> 1), vcol = (2 * (wid & 1) + hi) * 32 + (lane & 3) * 8;
  const bf16_t* vg0 = Vh + (long)vkey * ldv + vcol;
  const unsigned wsl = (unsigned)wid * 1024u;
#define DMA_K(t, slot) do { const bf16_t* kg_ = kg0 + (long)(t) * KVBLK * ldk; \
    _Pragma("unroll") for (int i_ = 0; i_ < NKC; ++i_) __builtin_amdgcn_global_load_lds((const unsigned*)(kg_ + i_ * 64), (LAS unsigned*)(lds + (slot) * SLOTK + i_ * 8192 + wsl), 16, 0, 0); } while (0)
#define DMA_V(t, slot) do { const bf16_t* vg_ = vg0 + (long)(t) * KVBLK * ldv; \
    __builtin_amdgcn_global_load_lds((const unsigned*)(vg_), (LAS unsigned*)(lds + VBASE + (slot) * SLOTV + wsl), 16, 0, 0); \
    __builtin_amdgcn_global_load_lds((const unsigned*)(vg_ + 32 * (long)ldv), (LAS unsigned*)(lds + VBASE + (slot) * SLOTV + 8192 + wsl), 16, 0, 0); } while (0)
#define WAIT_BARN(full) do { if (full) { if (NKC == 3) asm volatile("s_waitcnt vmcnt(5) lgkmcnt(0)" ::: "memory"); else asm volatile("s_waitcnt vmcnt(4) lgkmcnt(0)" ::: "memory"); } \
    else asm volatile("s_waitcnt vmcnt(0) lgkmcnt(0)" ::: "memory"); __builtin_amdgcn_s_barrier(); asm volatile("" ::: "memory"); } while (0)
#define WAIT_BAR() do { asm volatile("s_waitcnt vmcnt(0) lgkmcnt(0)" ::: "memory"); __builtin_amdgcn_s_barrier(); asm volatile("" ::: "memory"); } while (0)
  int kb[4];
  { const int sw = (r32 >> 1) & 7, u = sw >> 1, t = hi ^ (sw & 1);
#pragma unroll
    for (int q = 0; q < 4; ++q) kb[q] = r32 * 128 + ((((q ^ u) * 2) + t) << 4); }
  const int vb0 = (int)(uintptr_t)(lds + VBASE) + v_rd_base(lane);
#define RESC(a) do { if (__any((a) < 1.f)) { if (hi == 0) al_l[r32] = (a); asm volatile("s_waitcnt lgkmcnt(0)" ::: "memory"); \
    _Pragma("unroll") for (int d = 0; d < 4; ++d) _Pragma("unroll") for (int r = 0; r < 16; ++r) o[d][r] *= al_l[crow(r, hi)]; } } while (0)
#define MASK(P0, P1, t) do { if (NA) na_mask(P0, P1, nc, krow0 + (t), hi); } while (0)
#define NEXT3(s) ((s) == 2 ? 0 : (s) + 1)
  f32x16 pA0, pA1, pB0, pB1; float mnA, mnB, alA, alB; bf16x8 pa0, pa1, pa2, pa3;
  DMA_K(0, 0); DMA_K(1, 1); DMA_V(0, 0); WAIT_BAR();
  DMA_K(2, 2); DMA_V(1, 1);
  qkt<DQ>(pA0, pA1, lds, kb, qr); MASK(pA0, pA1, 0); partialSM<DQ>(pA0, pA1, m_reg, mnA, alA);
  int kc = 1, kn = 3, vp = 0, vn = 2;
#define ADV() do { kc = (kc + 1) & 3; kn = (kn + 1) & 3; vp = (vp == 2 ? 0 : vp + 1); vn = (vn == 2 ? 0 : vn + 1); } while (0)
  for (int j = 1; j + 1 < NT; j += 2) {
    { const bool full = j + 2 < NT; if (full) { DMA_K(j + 2, kn); } DMA_V(j + 1, vn);
      SBAR(); qkt<DQ>(pB0, pB1, lds + kc * SLOTK, kb, qr); MASK(pB0, pB1, j);
      finishSM(pA0, pA1, alA, l_reg, pa0, pa1, pa2, pa3); SBAR();
      pv_d0(o, vb0 + vp * SLOTV, pa0, pa1, pa2, pa3); partialSM<DQ>(pB0, pB1, m_reg, mnB, alB);
      RESC(alB); WAIT_BARN(full); ADV(); }
    { const bool full = j + 3 < NT; if (full) { DMA_K(j + 3, kn); } DMA_V(j + 2, vn);
      SBAR(); qkt<DQ>(pA0, pA1, lds + kc * SLOTK, kb, qr); MASK(pA0, pA1, j + 1);
      finishSM(pB0, pB1, alB, l_reg, pa0, pa1, pa2, pa3); SBAR();
      pv_d0(o, vb0 + vp * SLOTV, pa0, pa1, pa2, pa3); partialSM<DQ>(pA0, pA1, m_reg, mnA, alA);
      RESC(alA); WAIT_BARN(full); ADV(); }
  }
  SBAR(); qkt<DQ>(pB0, pB1, lds + kc * SLOTK, kb, qr); MASK(pB0, pB1, NT - 1);
  finishSM(pA0, pA1, alA, l_reg, pa0, pa1, pa2, pa3); SBAR();
  pv_d0(o, vb0 + vp * SLOTV, pa0, pa1, pa2, pa3); partialSM<DQ>(pB0, pB1, m_reg, mnB, alB);
  RESC(alB);
  finishSM(pB0, pB1, alB, l_reg, pa0, pa1, pa2, pa3); SBAR();
  pv_d0(o, vb0 + (vp == 2 ? 0 : vp + 1) * SLOTV, pa0, pa1, pa2, pa3);
  if (hi == 0) li_l[r32] = l_reg; asm volatile("s_waitcnt lgkmcnt(0)" ::: "memory");
  float rli[16];
#pragma unroll
  for (int r = 0; r < 16; ++r) rli[r] = __builtin_amdgcn_rcpf(li_l[crow(r, hi)]);
  bf16_t* Ow = Ob + (long)(wid * QBLK) * ldo;
  { if (((NT - 1) & 3) != 3) WAIT_BAR();
    LAS bf16_t* stg = (LAS bf16_t*)(lds + wid * 8192);
#pragma unroll
    for (int r = 0; r < 16; ++r) { const int orow = crow(r, hi);
#pragma unroll
      for (int d0 = 0; d0 < 4; ++d0) stg[orow * 128 + d0 * 32 + r32] = f2bf(o[d0][r] * rli[r]); }
    asm volatile("s_waitcnt lgkmcnt(0)" ::: "memory");
#pragma unroll
    for (int i = 0; i < 8; ++i) { const int row = i * 4 + (lane >> 4), ch = lane & 15; const u32x4 v = *(const LAS u32x4*)(stg + row * 128 + ch * 8); *(u32x4*)(Ow + (long)row * ldo + ch * 8) = v; } }
  WAIT_BAR();
#undef DMA_K
#undef DMA_V
#undef WAIT_BARN
#undef ADV
#undef WAIT_BAR
#undef RESC
#undef MASK
#undef NEXT3
}
#undef SBAR
}
#define XB_TMO      128
#define XB_XCNT(j)  (256  + 64 * (j))
#define XB_XSUB(j)  (1280 + 64 * (j))
#define XB_XGEN(j)  (2304 + 64 * (j))
#define XB_TOP      3328
#define XB_TOPGEN   3392
#define XCD_BAR_WORDS 3456
#define XB_SPIN_CAP (1u << 18)
constexpr size_t OFF_BAR = 23 * MiB;
__device__ __forceinline__ unsigned xb_ld(unsigned* p)              { return __hip_atomic_load(p, __ATOMIC_RELAXED, __HIP_MEMORY_SCOPE_AGENT); }
__device__ __forceinline__ unsigned xb_add(unsigned* p, unsigned v) { return __hip_atomic_fetch_add(p, v, __ATOMIC_RELAXED, __HIP_MEMORY_SCOPE_AGENT); }
__device__ __forceinline__ unsigned xb_xcc_id() { return (unsigned)__builtin_amdgcn_s_getreg((3 << 11) | 20) & 0xFu; }
#define XB_SPIN(cond, bar) do { unsigned _sp = 0; while (cond) { __builtin_amdgcn_s_sleep(1); \
    if ((++_sp & 255u) == 0u) { if (xb_ld(&(bar)[XB_TMO])) break; if (_sp > XB_SPIN_CAP) { atomicAdd(&(bar)[XB_TMO], 1u); break; } } } } while (0)
struct XcdBarrier { unsigned* bar; unsigned x; volatile LAS unsigned* st; };
__device__ __forceinline__ XcdBarrier xcd_barrier_post(unsigned* bar, volatile LAS unsigned* st) {
    XcdBarrier b; b.bar = bar; b.x = xb_xcc_id(); b.st = st;
    if (threadIdx.x == 0) (void)xb_add(&bar[XB_XCNT(b.x)], 1u);
    return b;
}
__device__ __forceinline__ void xcd_barrier_complete(unsigned* bar, unsigned x, unsigned& nloc, unsigned& nx) {
    const unsigned G = gridDim.x * gridDim.y * gridDim.z;
    unsigned sum, cnt, mine, sp = 0u;
    for (;;) {
        sum = 0u; cnt = 0u; mine = 0u;
#pragma unroll
        for (unsigned j = 0; j < 16; ++j) { const unsigned c = xb_ld(&bar[XB_XCNT(j)]); sum += c; cnt += (c > 0u) ? 1u : 0u; mine = (j == x) ? c : mine; }
        if (sum == G) break;
        __builtin_amdgcn_s_sleep(1);
        if ((++sp & 255u) == 0u) { if (xb_ld(&bar[XB_TMO])) break; if (sp > XB_SPIN_CAP) { atomicAdd(&bar[XB_TMO], 1u); break; } }
    }
    nloc = mine > 0u ? mine : 1u; nx = cnt > 0u ? cnt : 1u;
}
__device__ __forceinline__ void xcd_barrier(const XcdBarrier& b) {
    asm volatile("s_waitcnt vmcnt(0)" ::: "memory");
    __syncthreads();
    if (threadIdx.x == 0) {
        unsigned* bar = b.bar;
        __builtin_amdgcn_s_waitcnt(0);
        unsigned nloc = b.st[0], nx = b.st[1];
        if (nloc == 0u) { xcd_barrier_complete(bar, b.x, nloc, nx); b.st[0] = nloc; b.st[1] = nx; }
        const unsigned old = xb_add(&bar[XB_XSUB(b.x)], 1u);
        const unsigned gen = old / nloc;
        if (old + 1u == (gen + 1u) * nloc) {
            __builtin_amdgcn_fence(__ATOMIC_RELEASE, "agent");
            asm volatile("s_waitcnt vmcnt(0)" ::: "memory");
            const unsigned og = xb_add(&bar[XB_TOP], 1u);
            const unsigned tg = og / nx;
            if (og + 1u == (tg + 1u) * nx) xb_add(&bar[XB_TOPGEN], 1u);
            else XB_SPIN(xb_ld(&bar[XB_TOPGEN]) == tg, bar);
            __builtin_amdgcn_fence(__ATOMIC_ACQUIRE, "agent");
            xb_add(&bar[XB_XGEN(b.x)], 1u);
            asm volatile("s_waitcnt vmcnt(0)" ::: "memory");
        } else {
            XB_SPIN(xb_ld(&bar[XB_XGEN(b.x)]) == gen, bar);
            __builtin_amdgcn_fence(__ATOMIC_ACQUIRE, "agent");
            asm volatile("s_waitcnt vmcnt(0)" ::: "memory");
        }
    }
    __syncthreads();
}
constexpr int LDS_BYTES = 151616;
constexpr int LDS_BTAB = 149504, LDS_BARST = 149504 + 2048;
constexpr int NPH = 38;
#define LDS_WAIT() asm volatile("s_waitcnt lgkmcnt(0)" ::: "memory")

__device__ __forceinline__ int drow_map(int kind, int n) {
    if (kind == 0) { if (n < 1024) return n; if (n < 1088) return 8192 + (n - 1024); return n - 64; }
    if (kind == 1) { const int h = n / 192, j = n % 192; if (j < 128) return h * 128 + j; if (j < 160) return 1024 + 256 * (h >> 2) + (h & 3) * 32 + (j - 128); return 1024 + 256 * (h >> 2) + 128 + (h & 3) * 32 + (j - 160); }
    if (kind == 2) { const int h = n / 256, j = n % 256; if (j < 128) return h * 128 + j; return 1024 + h * 128 + (j - 128); }
    return n;
}
struct TrItem { const float* src; const float* gain; bf16_t* dst; int N, K; };
__device__ __forceinline__ bool tr_decode(const Args& a, int it, TrItem& t) {
    constexpr int PER_LAYER = 29632;
    if (it >= DEPTH * PER_LAYER) return false;
    const int l = it / PER_LAYER; int r = it % PER_LAYER;
    unsigned char* wl = a.ws + OFF_W + (size_t)l * WL_STRIDE;
    const float* W; int K, N, kind = 3; bf16_t* WT; const float* gain = nullptr;
    if (r < 8256) { W = a.in[I_WIN] + (size_t)l * DM * INT; K = 2048; N = INT; WT = (bf16_t*)(wl + WL_IN); kind = 0; }
    else if ((r -= 8256) < 384) { W = a.in[I_WUQ] + (size_t)l * 512 * 1536; K = 512; N = 1536; WT = (bf16_t*)(wl + WL_UQ); kind = 1; gain = a.in[I_NQA] + (size_t)l * 512; }
    else if ((r -= 384) < 512) { W = a.in[I_WUKV] + (size_t)l * 512 * 2048; K = 512; N = 2048; WT = (bf16_t*)(wl + WL_UKV); kind = 2; gain = a.in[I_NKVA] + (size_t)l * 512; }
    else if ((r -= 512) < 1024) { W = a.in[I_WOA] + (size_t)l * 1024 * 2048; K = 1024; N = 2048; WT = (bf16_t*)(wl + WL_OA); }
    else if ((r -= 1024) < 1024) { W = a.in[I_WOB] + (size_t)l * 1024 * 2048; K = 1024; N = 2048; WT = (bf16_t*)(wl + WL_OB); }
    else if ((r -= 1024) < 2048) { W = a.in[I_WOUT] + (size_t)l * 2048 * 2048; K = 2048; N = 2048; WT = (bf16_t*)(wl + WL_OUT); }
    else if ((r -= 2048) < 8192) { W = a.in[I_WFF1] + (size_t)l * DM * DFF; K = 2048; N = DFF; WT = (bf16_t*)(wl + WL_FF1); }
    else { r -= 8192; W = a.in[I_WFF2] + (size_t)l * DFF * DM; K = DFF; N = 2048; WT = (bf16_t*)(wl + WL_FF2); }
    const int nblk = N / 32, kb = r / nblk, nb = r % nblk, k0 = kb * 64, n0 = nb * 32;
    t.src = W + (size_t)k0 * N + n0; t.gain = gain ? gain + k0 : nullptr; t.dst = WT + (size_t)drow_map(kind, n0) * K + k0; t.N = N; t.K = K; return true;
}
__device__ __forceinline__ void tr_load(const TrItem& t, f32x4 (&v)[8], float (&gv)[8], int lane) {
#pragma unroll
    for (int i = 0; i < 8; ++i) { const int kk = 8 * i + (lane >> 3); v[i] = __builtin_nontemporal_load((const f32x4*)(t.src + (size_t)kk * t.N + (lane & 7) * 4)); gv[i] = t.gain ? t.gain[kk] : 1.0f; }
}
__device__ __forceinline__ void tr_store(const TrItem& t, const f32x4 (&v)[8], const float (&gv)[8], LAS float* scr, int lane) {
#pragma unroll
    for (int i = 0; i < 8; ++i) { const int kk = 8 * i + (lane >> 3); const f32x4 x = v[i] * gv[i];
        LAS float* d = scr + kk * 33 + (lane & 7) * 4; d[0] = x[0]; d[1] = x[1]; d[2] = x[2]; d[3] = x[3]; }
    LDS_WAIT(); asm volatile("" ::: "memory");
    const int c = lane & 7;
#pragma unroll
    for (int j = 0; j < 4; ++j) { const int n = (lane >> 3) + 8 * j; const LAS float* s = scr + (8 * c) * 33 + n;
        u32x4 o; o.x = cvt_pk_bf16(s[0 * 33], s[1 * 33]); o.y = cvt_pk_bf16(s[2 * 33], s[3 * 33]); o.z = cvt_pk_bf16(s[4 * 33], s[5 * 33]); o.w = cvt_pk_bf16(s[6 * 33], s[7 * 33]);
        *(u32x4*)(t.dst + (size_t)n * t.K + 8 * c) = o; }
    LDS_WAIT(); asm volatile("" ::: "memory");
}
__device__ __forceinline__ void prologue(const Args& a, LAS unsigned char* lds) {
    int tid_ = threadIdx.x; asm volatile("" : "+v"(tid_));
    const int tid = tid_, lane = tid & 63, wave = tid >> 6, G = gridDim.x;
    float2* CS = (float2*)(a.ws + OFF_CS);
    for (int idx = blockIdx.x * 512 + tid; idx < S * 32; idx += G * 512) { const int pos = idx >> 5, i = idx & 31; float c, s; sincos_acc((float)pos * inv_freq(i), c, s); CS[idx] = make_float2(c, s); }
    LAS float* scr = (LAS float*)(lds + wave * 8448);
    const int gw = blockIdx.x * 8 + wave, NGW = G * 8;
    TrItem cur, nxt; f32x4 v[8], vn[8]; float gv[8], gn[8];
    bool have = tr_decode(a, gw, cur);
    if (have) tr_load(cur, v, gv, lane);
    for (int it = gw; have; it += NGW) {
        const bool hn = tr_decode(a, it + NGW, nxt);
        if (hn) tr_load(nxt, vn, gn, lane);
        tr_store(cur, v, gv, scr, lane);
        cur = nxt; have = hn;
#pragma unroll
        for (int i = 0; i < 8; ++i) { v[i] = vn[i]; gv[i] = gn[i]; }
    }
}
template <bool F32OUT>
__device__ __forceinline__ void norm_phase(const float* X, const float* g, bf16_t* Ub, float* Of) {
    int tid_ = threadIdx.x; asm volatile("" : "+v"(tid_));
    const int lane = tid_ & 63, gw = blockIdx.x * 8 + (tid_ >> 6), NGW = gridDim.x * 8;
    for (int row = gw; row < S; row += NGW) {
        const f32x4* xr = (const f32x4*)(X + (size_t)row * DM);
        f32x4 v[8]; float ss = 0.f;
#pragma unroll
        for (int j = 0; j < 8; ++j) { v[j] = xr[lane + 64 * j]; ss += (v[j][0] * v[j][0] + v[j][1] * v[j][1]) + (v[j][2] * v[j][2] + v[j][3] * v[j][3]); }
#pragma unroll
        for (int o = 1; o < 64; o <<= 1) ss += __shfl_xor(ss, o);
        const float rinv = rsqrtf(ss * (1.0f / DM) + EPS);
        const f32x4* gr = (const f32x4*)g;
#pragma unroll
        for (int j = 0; j < 8; ++j) { const f32x4 o = v[j] * rinv * gr[lane + 64 * j];
            if (F32OUT) ((f32x4*)(Of + (size_t)row * DM))[lane + 64 * j] = o;
            else ((uint2*)(Ub + (size_t)row * DM))[lane + 64 * j] = make_uint2(cvt_pk_bf16(o[0], o[1]), cvt_pk_bf16(o[2], o[3])); }
    }
}
__device__ __forceinline__ void norm_kpe_phase(const float* X, const float* g, bf16_t* Ub, const bf16_t* Wk, const float2* CS, bf16_t* KM, LAS unsigned char* lds) {
    constexpr int PITCH = 4096 + 16;
    int tid_ = threadIdx.x; asm volatile("" : "+v"(tid_));
    const int tid = tid_, lane = tid & 63, wid = tid >> 6, r32 = lane & 31, hi = lane >> 5;
    for (int rb = blockIdx.x; rb < S / 32; rb += gridDim.x) {
        const int base = rb * 32;
#pragma unroll 1
        for (int rr = 0; rr < 4; ++rr) { const int lr = 4 * wid + rr, row = base + lr;
            const f32x4* xr = (const f32x4*)(X + (size_t)row * DM); f32x4 v[8]; float ss = 0.f;
#pragma unroll
            for (int j = 0; j < 8; ++j) { v[j] = xr[lane + 64 * j]; ss += (v[j][0] * v[j][0] + v[j][1] * v[j][1]) + (v[j][2] * v[j][2] + v[j][3] * v[j][3]); }
#pragma unroll
            for (int o = 1; o < 64; o <<= 1) ss += __shfl_xor(ss, o);
            const float rinv = rsqrtf(ss * (1.0f / DM) + EPS); const f32x4* gr = (const f32x4*)g;
#pragma unroll
            for (int j = 0; j < 8; ++j) { const f32x4 o = v[j] * rinv * gr[lane + 64 * j]; typedef unsigned u32x2 __attribute__((ext_vector_type(2))); const u32x2 w = {cvt_pk_bf16(o[0], o[1]), cvt_pk_bf16(o[2], o[3])};
                ((u32x2*)(Ub + (size_t)row * DM))[lane + 64 * j] = w; *(LAS u32x2*)(lds + lr * PITCH + (lane + 64 * j) * 8) = w; } }
        __syncthreads();
        att::f32x16 a0 = {}, a1 = {};
#pragma unroll 4
        for (int ks = 0; ks < 16; ++ks) { const int k0 = 256 * wid + 16 * ks + hi * 8;
            const bf16x8 w0 = *(const bf16x8*)(Wk + (size_t)r32 * 2048 + k0), w1 = *(const bf16x8*)(Wk + (size_t)(32 + r32) * 2048 + k0);
            const bf16x8 uu = *(const LAS bf16x8*)(lds + r32 * PITCH + k0 * 2);
            a0 = __builtin_amdgcn_mfma_f32_32x32x16_bf16(w0, uu, a0, 0, 0, 0); a1 = __builtin_amdgcn_mfma_f32_32x32x16_bf16(w1, uu, a1, 0, 0, 0); }
        __syncthreads();
        LAS float* P = (LAS float*)lds;
#pragma unroll
        for (int r = 0; r < 16; ++r) { P[(wid * 32 + r) * 64 + lane] = a0[r]; P[(wid * 32 + 16 + r) * 64 + lane] = a1[r]; }
        __syncthreads();
#pragma unroll
        for (int rr = 0; rr < 2; ++rr) { const int r = 2 * wid + rr; float x1 = 0.f, x2 = 0.f;
#pragma unroll
            for (int w = 0; w < 8; ++w) { x1 += P[(w * 32 + r) * 64 + lane]; x2 += P[(w * 32 + 16 + r) * 64 + lane]; }
            const int row = base + r32, i = att::crow(r, hi); const float2 cs = CS[(size_t)row * 32 + i];
            const bf16_t o1 = f2bf(x1 * cs.x - x2 * cs.y), o2 = f2bf(x2 * cs.x + x1 * cs.y);
            bf16_t* kr = KM + (size_t)row * 1536 + 128 + i;
#pragma unroll
            for (int h = 0; h < 8; ++h) { kr[h * 192] = o1; kr[h * 192 + 32] = o2; } }
        __syncthreads();
    }
}
#ifndef ATT_V2
#define ATT_V2 1
#endif
#if ATT_V2
#define ATTNS att2
#define ATT_LDS(p) ((LAS unsigned char*)(p))
#else
#define ATTNS att
#define ATT_LDS(p) ((char*)(p))
#endif
__device__ __forceinline__ void attn_phase(const Args& a, int l, unsigned char* lds) {
    unsigned char* ws = a.ws; asm volatile("" : "+s"(ws));
    int tid_ = threadIdx.x; asm volatile("" : "+v"(tid_));
    const int c = blockIdx.x, G = gridDim.x, tid = tid_, wid = tid >> 6, r32 = tid & 31;
    const att::NaCtx nc0{nullptr, 0, 0, 0, 0};
#ifndef NO_MLA
    for (int uidx = c; uidx < 256; uidx += G) { const int h = uidx & 7, qb = uidx >> 3;
        ATTNS::attn_unit<192, false>((const bf16_t*)(ws + OFF_QM) + (size_t)qb * 256 * 1536 + h * 192, 1536, (const bf16_t*)(ws + OFF_KM) + h * 192, 1536,
                                   (const bf16_t*)(ws + OFF_VM) + h * 128, 1024, (bf16_t*)(ws + OFF_ATA) + (size_t)qb * 256 * 1024 + h * 128, 1024, S / 64, ATT_LDS(lds), nc0, 0); }
#endif
#ifndef NO_NA
    float* btab = (float*)(lds + LDS_BTAB);
    for (int uidx = c; uidx < 256; uidx += G) { const int h = uidx & 7, g4 = uidx >> 3, r0 = 4 * g4, kr0 = min(max(r0 - 4, 0), 116);
        __syncthreads();
        if (tid < 465) btab[tid] = a.in[I_RPB][((size_t)l * 8 + h) * 465 + tid] * 11.313708498984761f;
        __syncthreads();
        att::NaCtx nc; nc.btab = btab; nc.r = r0 + (wid >> 1); nc.qc = (wid & 1) * 32 + r32; nc.cstart = min(max(nc.qc - 8, 0), 48); nc.wstart = min(max(nc.r - 4, 0), 120);
        att::attn_unit<128, true>((const bf16_t*)(ws + OFF_QNA) + (size_t)r0 * 64 * 1024 + h * 128, 1024, (const bf16_t*)(ws + OFF_KNA) + (size_t)kr0 * 64 * 1024 + h * 128, 1024,
                                  (const bf16_t*)(ws + OFF_VNA) + (size_t)kr0 * 64 * 1024 + h * 128, 1024, (bf16_t*)(ws + OFF_ATB) + (size_t)r0 * 64 * 1024 + h * 128, 1024, 12, (char*)lds, nc, kr0); }
#endif
}
#ifndef ONLY
#define ONLY -1
#endif
#define PHS(k) (ONLY < 0 || ONLY == (k))
__global__ void __launch_bounds__(512) mega(Args a) {
    extern __shared__ __attribute__((aligned(16))) unsigned char lds[];
    cg::grid_group grid = cg::this_grid();
    LAS unsigned char* ldsl = (LAS unsigned char*)lds;
    const int G = gridDim.x, c = blockIdx.x;
    volatile LAS unsigned* bst = (volatile LAS unsigned*)(ldsl + LDS_BARST);
    if (threadIdx.x < 2) bst[threadIdx.x] = 0u;
    __syncthreads();
    XcdBarrier xbar; xbar.bar = (unsigned*)(a.ws + OFF_BAR); xbar.x = 0; xbar.st = bst;
    if (a.ph_hi - a.ph_lo > 1) xbar = xcd_barrier_post((unsigned*)(a.ws + OFF_BAR), bst);
#define GRID_BAR() xcd_barrier(xbar)
#ifdef REPEAT_PRO
    if (a.ph_lo == 0) { prologue(a, ldsl); grid.sync(); }
#endif
    if (PHS(100) && a.ph_lo == 0) { prologue(a, ldsl); if (a.ph_hi > 1) grid.sync(); }
    const int plo = a.ph_lo < 1 ? 1 : a.ph_lo, phi = a.ph_hi > NPH - 1 ? NPH - 1 : a.ph_hi;
    for (int ph = plo; ph < phi; ++ph) {
#ifdef REPEAT_K
        for (int rep = 0; rep < (((ph - 1) % 9 == REPEAT_K) ? 2 : 1); ++rep) {
            if (rep) GRID_BAR();
#else
        {
#endif
            unsigned char* ws = a.ws; asm volatile("" : "+s"(ws));
            const int l = (ph - 1) / 9, k = (ph - 1) % 9;
            const float* xin = (l == 0) ? a.in[I_X] : a.out;
            unsigned char* wl = ws + OFF_W + (size_t)l * WL_STRIDE;
            if (PHS(0) && k == 0) norm_kpe_phase(xin, a.in[I_NMIX] + (size_t)l * DM, (bf16_t*)(ws + OFF_U), (const bf16_t*)(wl + WL_IN) + (size_t)8192 * 2048, (const float2*)(ws + OFF_CS), (bf16_t*)(ws + OFF_KM), ldsl);
            else if (PHS(1) && k == 1) {
                pg8::Gemm g{(const bf16_t*)(ws + OFF_U), nullptr, (const bf16_t*)(wl + WL_IN), nullptr, 2048}; pg8::StaticOrder so; so.init(S, 8192, G, c);
                pg8::EpiInF E{(bf16_t*)(ws + OFF_CQ), (bf16_t*)(ws + OFF_CKV), (bf16_t*)(ws + OFF_QNA), (bf16_t*)(ws + OFF_KNA), (bf16_t*)(ws + OFF_VNA), (bf16_t*)(ws + OFF_KM),
                              (f16_t*)(ws + OFF_GA), (f16_t*)(ws + OFF_GB), (float*)(ws + OFF_SSQ), (float*)(ws + OFF_KPER), (const float2*)(ws + OFF_CS)};
                pg8::gemm_phase<pg8::EpiInF, pg8::StaticOrder>(ldsl, g, so, E);
            } else if (PHS(2) && k == 2) {
                pg8::Gemm g{(const bf16_t*)(ws + OFF_CQ), (const bf16_t*)(ws + OFF_CKV), (const bf16_t*)(wl + WL_UQ), (const bf16_t*)(wl + WL_UKV), 512}; pg8::SchedQKV sq; sq.init(G, c);
                pg8::EpiQKVF E{(bf16_t*)(ws + OFF_QM), (bf16_t*)(ws + OFF_KM), (bf16_t*)(ws + OFF_VM), (const float*)(ws + OFF_SSQ), (const float2*)(ws + OFF_CS)};
                pg8::gemm_phase<pg8::EpiQKVF, pg8::SchedQKV>(ldsl, g, sq, E);
            } else if (PHS(3) && k == 3) attn_phase(a, l, lds);
            else if (PHS(4) && k == 4) {
                pg8::Gemm g{(const bf16_t*)(ws + OFF_ATA), (const bf16_t*)(ws + OFF_ATB), (const bf16_t*)(wl + WL_OA), (const bf16_t*)(wl + WL_OB), 1024}; pg8::SchedO sq; sq.init(G, c);
                pg8::EpiOF E{(float*)(ws + OFF_T), (const f16_t*)(ws + OFF_GA), (const f16_t*)(ws + OFF_GB), (bf16_t*)(ws + OFF_MRG)};
                pg8::gemm_phase<pg8::EpiOF, pg8::SchedO>(ldsl, g, sq, E);
            } else if (PHS(5) && k == 5) {
                pg8::Gemm g{(const bf16_t*)(ws + OFF_MRG), nullptr, (const bf16_t*)(wl + WL_OUT), nullptr, 2048}; pg8::StaticOrder so; so.init(S, 2048, G, c);
                pg8::EpiResF E{xin, a.out};
                pg8::gemm_phase<pg8::EpiResF, pg8::StaticOrder>(ldsl, g, so, E);
            } else if (PHS(6) && k == 6) norm_phase<false>(a.out, a.in[I_NMLP] + (size_t)l * DM, (bf16_t*)(ws + OFF_U), nullptr);
            else if (PHS(7) && k == 7) {
                pg8::Gemm g{(const bf16_t*)(ws + OFF_U), nullptr, (const bf16_t*)(wl + WL_FF1), nullptr, 2048}; pg8::StaticOrder so; so.init(S, DFF, G, c);
                pg8::EpiFF1F E{(bf16_t*)(ws + OFF_H)};
                pg8::gemm_phase<pg8::EpiFF1F, pg8::StaticOrder>(ldsl, g, so, E);
            } else if (PHS(8)) {
                pg8::Gemm g{(const bf16_t*)(ws + OFF_H), nullptr, (const bf16_t*)(wl + WL_FF2), nullptr, DFF}; pg8::StaticOrder so; so.init(S, 2048, G, c);
                pg8::EpiResF E{a.out, a.out};
                pg8::gemm_phase<pg8::EpiResF, pg8::StaticOrder>(ldsl, g, so, E);
            }
        }
#ifdef EXTRA_SYNC
        GRID_BAR();
#endif
        if (ph + 1 < a.ph_hi) GRID_BAR();
    }
    if (PHS(101) && a.ph_hi == NPH) norm_phase<true>(a.out, a.in[I_NFIN], nullptr, a.out);
}
#ifndef MODE
#define MODE 1
#endif
#ifndef FASTMASK
#define FASTMASK 0x1ff
#endif
#ifndef FASTPRO
#define FASTPRO 1
#endif
extern "C" void kernel_launch(void* const* d_in, const int* in_sizes, int n_in, void* d_out, int out_size, void* d_ws, size_t ws_size, hipStream_t stream) {
    static int grid = 0;
    if (grid == 0) {
        if (n_in != 15 || out_size != S * DM || ws_size < WS_END) { fprintf(stderr, "kernel_launch: bad shapes n_in %d out %d ws %zu (need %zu)\n", n_in, out_size, ws_size, (size_t)WS_END); grid = -1; return; }
        if (hipFuncSetAttribute((const void*)mega, hipFuncAttributeMaxDynamicSharedMemorySize, LDS_BYTES) != hipSuccess) { fprintf(stderr, "kernel_launch: hipFuncSetAttribute failed\n"); grid = -1; return; }
        int dev = 0, cus = 0, per_cu = 0;
        hipGetDevice(&dev); hipDeviceGetAttribute(&cus, hipDeviceAttributeMultiprocessorCount, dev);
        hipOccupancyMaxActiveBlocksPerMultiprocessor(&per_cu, (const void*)mega, 512, LDS_BYTES);
        if (per_cu < 1) { fprintf(stderr, "kernel_launch: occupancy query says %d blocks/CU\n", per_cu); per_cu = 1; }
        (void)hipGetLastError();
        grid = cus;
        fprintf(stderr, "kernel_launch: cus %d per_cu %d grid %d\n", cus, per_cu, grid);
    }
    if (grid < 0) return;
    Args a{}; fill_args(a, d_in, d_out, d_ws);
    if (hipMemsetAsync((char*)d_ws + OFF_BAR, 0, 16384, stream) != hipSuccess) { fprintf(stderr, "kernel_launch: memset failed\n"); return; }
#if MODE == 1
    a.ph_lo = 0; a.ph_hi = NPH;
    void* args[] = {&a};
    hipError_t e = hipLaunchCooperativeKernel((const void*)mega, dim3(grid), dim3(512), args, LDS_BYTES, stream);
    if (e != hipSuccess) fprintf(stderr, "cooperative launch failed: %s (grid %d)\n", hipGetErrorString(e), grid);
#else
    const Bufs b = get_bufs(a.ws);
    naive_prologue(a, b, stream);
    if (FASTPRO) { a.ph_lo = 0; a.ph_hi = 1; hipLaunchKernelGGL(mega, dim3(grid), dim3(512), LDS_BYTES, stream, a); }
    for (int l = 0; l < DEPTH; ++l) for (int k = 0; k < 9; ++k) {
        if ((FASTMASK >> k) & 1) { a.ph_lo = 1 + 9 * l + k; a.ph_hi = a.ph_lo + 1; hipLaunchKernelGGL(mega, dim3(grid), dim3(512), LDS_BYTES, stream, a); }
        else naive_stage(l, k, a, b, stream);
    }
    naive_final(a, stream);
#endif
}
```
